# Optimizing an MI355X kernel written in HIP

```python
import math
import jax, jax.numpy as jnp
from jax import lax
import numpy as np

D_MODEL = 1024
BATCH = 32
SEQ = 2048
DEPTH = 2

GRID_W = 64
CTX_LEN = 256
BRANCH_WIDTH = D_MODEL // 2
MIX_WIDTH = 2 * BRANCH_WIDTH
LRU_HEAD_DIM = 64
LRU_HEADS = BRANCH_WIDTH // LRU_HEAD_DIM
LRU_CONV = 4
LRU_C = 8.0
SGU_CHUNK = 128
SGU_GROUPS = 4
SGU_GROUP_DIM = BRANCH_WIDTH // SGU_GROUPS
SCONV_K = 3
DIFF_V_DIM = 128
DIFF_HEADS = BRANCH_WIDTH // DIFF_V_DIM
DIFF_HEAD_DIM = DIFF_V_DIM // 2
Q_BLOCK = 128
ROPE_BASE = 10000.0
AB_IN = 5 * BRANCH_WIDTH
CD_IN = 8 * BRANCH_WIDTH
N_AB = (DEPTH + 1) // 2
N_CD = DEPTH // 2
DEEPNORM_ALPHA = (2 * DEPTH) ** 0.25
DEEPNORM_BETA = (8 * DEPTH) ** -0.25
LN_EPS = 1e-5

kernel_name = "hybrid_lru_sgu_conv_diffattn_trunk"


def layer_norm(x, g, b):
    xf = x.astype(jnp.float32)
    mu = jnp.mean(xf, axis=-1, keepdims=True)
    var = jnp.mean(jnp.square(xf - mu), axis=-1, keepdims=True)
    return ((xf - mu) * lax.rsqrt(var + LN_EPS)).astype(x.dtype) * g + b


def rms_norm(x, g):
    xf = x.astype(jnp.float32)
    return (xf * lax.rsqrt(jnp.mean(jnp.square(xf), axis=-1, keepdims=True) + LN_EPS)).astype(x.dtype) * g


def modulation(cond, w, b):
    m = jax.nn.silu(cond) @ w + b
    shift, scale, gate = jnp.split(m[:, None, :], 3, axis=-1)
    return shift, scale, gate


def depthwise_conv(x, w, b=None):
    k = w.shape[0]
    y = lax.conv_general_dilated(x, w[:, None, :].astype(x.dtype), (1,), [(k // 2, k - 1 - k // 2)],
                                 dimension_numbers=('NWC', 'WIO', 'NWC'), feature_group_count=x.shape[-1])
    if b is not None:
        y = y + b
    return y


def rglru_coeffs(xc, w_a, b_a, w_x, b_x, lam):
    bsz, n, _ = xc.shape
    xh = xc.reshape(bsz, n, LRU_HEADS, LRU_HEAD_DIM)
    gate_r = jax.nn.sigmoid(jnp.einsum('blhi,hij->blhj', xh, w_a).reshape(bsz, n, BRANCH_WIDTH) + b_a)
    gate_i = jax.nn.sigmoid(jnp.einsum('blhi,hij->blhj', xh, w_x).reshape(bsz, n, BRANCH_WIDTH) + b_x)
    log_a = (-LRU_C * gate_r.astype(jnp.float32)) * jax.nn.softplus(-lam.astype(jnp.float32))
    a = jnp.exp(log_a)
    bterm = jnp.sqrt(-jnp.expm1(2.0 * log_a)) * (gate_i * xc).astype(jnp.float32)
    return a, bterm


def _scan_combine(left, right):
    a_l, h_l = left
    a_r, h_r = right
    return a_l * a_r, a_r * h_l + h_r


def linear_scan(a, b, reverse, h0=None):
    if h0 is not None:
        edge = -1 if reverse else 0
        b = b.at[:, edge].add(a[:, edge] * h0)
    return lax.associative_scan(_scan_combine, (a, b), reverse=reverse, axis=1)[1]


def spatial_gating(u, v, ln_g, ln_b, w_s, b_s):
    bsz, n, _ = v.shape
    vh = layer_norm(v, ln_g, ln_b).reshape(bsz, n // SGU_CHUNK, SGU_CHUNK, SGU_GROUPS, SGU_GROUP_DIM)
    s = jnp.einsum('gpq,bnqgc->bnpgc', w_s, vh) + b_s.T[:, :, None]
    return u * s.reshape(bsz, n, BRANCH_WIDTH)


def axial_rope(n_tokens):
    rows = n_tokens // GRID_W
    row = jnp.repeat(jnp.arange(rows, dtype=jnp.float32), GRID_W)
    col = jnp.tile(jnp.arange(GRID_W, dtype=jnp.float32), rows)
    n_freq = DIFF_HEAD_DIM // 4
    inv = ROPE_BASE ** (-jnp.arange(n_freq, dtype=jnp.float32) / n_freq)
    ang_r = row[:, None] * inv
    ang_c = col[:, None] * inv
    ang = jnp.concatenate([ang_r, ang_r, ang_c, ang_c], axis=-1)
    return jnp.cos(ang), jnp.sin(ang)


def apply_rope(x, cos, sin):
    n_freq = DIFF_HEAD_DIM // 4
    xs = x.reshape(x.shape[:-1] + (2, 2, n_freq))
    rot = jnp.stack([-xs[..., 1, :], xs[..., 0, :]], axis=-2).reshape(x.shape)
    cos = cos[:, None, None, :].astype(x.dtype)
    sin = sin[:, None, None, :].astype(x.dtype)
    return x * cos + rot * sin


def diff_attention(q, k, v, lam):
    s = jnp.einsum('bqhmd,bkhmd->bhmqk', q, k).astype(jnp.float32) * (DIFF_HEAD_DIM ** -0.5)
    p = jax.nn.softmax(s, axis=-1)
    a = p[:, :, 0] - lam * p[:, :, 1]
    return jnp.einsum('bhqk,bkhe->bqhe', a.astype(v.dtype), v)


def blocked_diff_attention(q, k, v, lam):
    bsz, n, nh, two, dh = q.shape
    qb = jnp.moveaxis(q.reshape(bsz, n // Q_BLOCK, Q_BLOCK, nh, two, dh), 1, 0)
    ob = lax.map(lambda qq: diff_attention(qq, k, v, lam), qb)
    return jnp.moveaxis(ob, 0, 1).reshape(bsz, n, nh, DIFF_V_DIM)


def ab_mixer(h, hc, w_in, w_out, conv_w, conv_b, w_a, b_a, w_x, b_x, lam,
             sgu_ln_g, sgu_ln_b, sgu_w, sgu_b, need_ctx_out):
    W = BRANCH_WIDTH
    p = h @ w_in
    pc = hc @ (w_in if need_ctx_out else w_in[:, :W])
    xl = depthwise_conv(p[..., :W], conv_w, conv_b)
    xc = depthwise_conv(pc[..., :W], conv_w, conv_b)
    h_lat = 0.0
    h_ctx_dirs = []
    for d, reverse in enumerate((False, True)):
        ac, bc = rglru_coeffs(xc, w_a[d], b_a[d], w_x[d], b_x[d], lam[d])
        hcd = linear_scan(ac, bc, reverse)
        h_end = hcd[:, 0] if reverse else hcd[:, -1]
        al, bl = rglru_coeffs(xl, w_a[d], b_a[d], w_x[d], b_x[d], lam[d])
        h_lat = h_lat + linear_scan(al, bl, reverse, h_end)
        h_ctx_dirs.append(hcd)

    def branches(pp, h_rec):
        y_a = h_rec.astype(pp.dtype) * jax.nn.silu(pp[..., W:2 * W])
        u = jax.nn.gelu(pp[..., 2 * W:3 * W])
        v = jax.nn.gelu(pp[..., 3 * W:4 * W])
        y_b = spatial_gating(u, v, sgu_ln_g, sgu_ln_b, sgu_w, sgu_b) * jax.nn.silu(pp[..., 4 * W:5 * W])
        return jnp.concatenate([y_a, y_b], axis=-1) @ w_out

    y = branches(p, h_lat)
    yc = branches(pc, h_ctx_dirs[0] + h_ctx_dirs[1]) if need_ctx_out else None
    return y, yc


def cd_mixer(h, hc, w_in, w_out, sconv_w, lam_vec, subln_g, lam_init, need_ctx_out):
    W = BRANCH_WIDTH
    bsz, n, _ = h.shape
    p = h @ w_in
    pc = hc @ (w_in if need_ctx_out else w_in[:, 5 * W:7 * W])
    kvc = pc[..., 5 * W:7 * W] if need_ctx_out else pc
    lam_f = lam_vec.astype(jnp.float32)
    lam = (jnp.exp(jnp.sum(lam_f[0] * lam_f[1])) - jnp.exp(jnp.sum(lam_f[2] * lam_f[3])) + lam_init)

    def heads_qk(t):
        return t.reshape(t.shape[0], t.shape[1], DIFF_HEADS, 2, DIFF_HEAD_DIM)

    def heads_v(t):
        return t.reshape(t.shape[0], t.shape[1], DIFF_HEADS, DIFF_V_DIM)

    cos, sin = axial_rope(n)
    q = apply_rope(heads_qk(p[..., 4 * W:5 * W]), cos, sin)
    k = apply_rope(heads_qk(p[..., 5 * W:6 * W]), cos, sin)
    v = heads_v(p[..., 6 * W:7 * W])
    kc = heads_qk(kvc[..., :W])
    vc = heads_v(kvc[..., W:])
    k_all = jnp.concatenate([kc, k], axis=1)
    v_all = jnp.concatenate([vc, v], axis=1)
    o = blocked_diff_attention(q, k_all, v_all, lam)

    def finish(pp, oo):
        y_c = pp[..., W:2 * W] * depthwise_conv(pp[..., 2 * W:3 * W] * pp[..., :W], sconv_w)
        y_c = y_c * jax.nn.silu(pp[..., 3 * W:4 * W])
        oo = rms_norm(oo, subln_g) * (1.0 - lam_init)
        y_d = oo.reshape(oo.shape[0], oo.shape[1], W) * jax.nn.silu(pp[..., 7 * W:8 * W])
        return jnp.concatenate([y_c, y_d], axis=-1) @ w_out

    y = finish(p, o)
    yc = None
    if need_ctx_out:
        oc = diff_attention(heads_qk(pc[..., 4 * W:5 * W]), kc, vc, lam)
        yc = finish(pc, oc)
    return y, yc


def setup_inputs(seed: int = 0) -> dict:
    key = jax.random.key(seed)
    ks = jax.random.split(key, 26)
    f32 = jnp.float32
    W = BRANCH_WIDTH

    def nrm(k, shape, s):
        return jax.random.normal(k, shape, f32) * s

    u = jax.random.uniform(ks[16], (N_AB, 2, W), f32, 0.9, 0.999)
    s = u ** (1.0 / LRU_C)
    return {
        "x": nrm(ks[0], (BATCH, SEQ, D_MODEL), 1.0),
        "c": nrm(ks[1], (BATCH, D_MODEL), 1.0),
        "ctx": nrm(ks[2], (BATCH, CTX_LEN, D_MODEL), 1.0),
        "c_ctx": nrm(ks[3], (D_MODEL,), 1.0),
        "w_mod": nrm(ks[4], (DEPTH, D_MODEL, 3 * D_MODEL), D_MODEL ** -0.5),
        "b_mod": nrm(ks[5], (DEPTH, 3 * D_MODEL), 0.02),
        "ln_g": 1.0 + nrm(ks[6], (DEPTH, D_MODEL), 0.02),
        "ln_b": nrm(ks[7], (DEPTH, D_MODEL), 0.02),
        "ab_w_in": nrm(ks[8], (N_AB, D_MODEL, AB_IN), D_MODEL ** -0.5),
        "ab_w_out": nrm(ks[9], (N_AB, MIX_WIDTH, D_MODEL), DEEPNORM_BETA * MIX_WIDTH ** -0.5),
        "lru_conv_w": nrm(ks[10], (N_AB, LRU_CONV, W), LRU_CONV ** -0.5),
        "lru_conv_b": nrm(ks[11], (N_AB, W), 0.02),
        "lru_w_a": nrm(ks[12], (N_AB, 2, LRU_HEADS, LRU_HEAD_DIM, LRU_HEAD_DIM), LRU_HEAD_DIM ** -0.5),
        "lru_b_a": nrm(ks[13], (N_AB, 2, W), 0.02),
        "lru_w_x": nrm(ks[14], (N_AB, 2, LRU_HEADS, LRU_HEAD_DIM, LRU_HEAD_DIM), LRU_HEAD_DIM ** -0.5),
        "lru_b_x": nrm(ks[15], (N_AB, 2, W), 0.02),
        "lru_lambda": jnp.log(s) - jnp.log1p(-s),
        "sgu_ln_g": 1.0 + nrm(ks[17], (N_AB, W), 0.02),
        "sgu_ln_b": nrm(ks[18], (N_AB, W), 0.02),
        "sgu_w": nrm(ks[19], (N_AB, SGU_GROUPS, SGU_CHUNK, SGU_CHUNK), SGU_CHUNK ** -0.5),
        "sgu_b": 1.0 + nrm(ks[20], (N_AB, SGU_GROUPS, SGU_CHUNK), 0.02),
        "cd_w_in": nrm(ks[21], (N_CD, D_MODEL, CD_IN), D_MODEL ** -0.5),
        "cd_w_out": nrm(ks[22], (N_CD, MIX_WIDTH, D_MODEL), DEEPNORM_BETA * MIX_WIDTH ** -0.5),
        "sconv_w": nrm(ks[23], (N_CD, SCONV_K, W), SCONV_K ** -0.5),
        "diff_lambda": nrm(ks[24], (N_CD, 4, DIFF_HEAD_DIM), 0.1),
        "diff_subln_g": 1.0 + nrm(ks[25], (N_CD, DIFF_V_DIM), 0.02),
    }


def reference(x, c, ctx, c_ctx, w_mod, b_mod, ln_g, ln_b, ab_w_in, ab_w_out, lru_conv_w, lru_conv_b,
              lru_w_a, lru_b_a, lru_w_x, lru_b_x, lru_lambda, sgu_ln_g, sgu_ln_b, sgu_w, sgu_b,
              cd_w_in, cd_w_out, sconv_w, diff_lambda, diff_subln_g):
    for l in range(DEPTH):
        need_ctx_out = l < DEPTH - 1
        shift, scale, gate = modulation(c, w_mod[l], b_mod[l])
        shift_c, scale_c, gate_c = modulation(c_ctx[None], w_mod[l], b_mod[l])
        h = x * (1.0 + scale) + shift
        hc = ctx * (1.0 + scale_c) + shift_c
        i = l // 2
        if l % 2 == 0:
            y, yc = ab_mixer(h, hc, ab_w_in[i], ab_w_out[i], lru_conv_w[i], lru_conv_b[i],
                             lru_w_a[i], lru_b_a[i], lru_w_x[i], lru_b_x[i], lru_lambda[i],
                             sgu_ln_g[i], sgu_ln_b[i], sgu_w[i], sgu_b[i], need_ctx_out)
        else:
            lam_init = 0.8 - 0.6 * math.exp(-0.3 * l)
            y, yc = cd_mixer(h, hc, cd_w_in[i], cd_w_out[i], sconv_w[i], diff_lambda[i],
                             diff_subln_g[i], lam_init, need_ctx_out)
        x = layer_norm(DEEPNORM_ALPHA * x + gate * y, ln_g[l], ln_b[l])
        if need_ctx_out:
            ctx = layer_norm(DEEPNORM_ALPHA * ctx + gate_c * yc, ln_g[l], ln_b[l])
    return x
```

```cpp
#include <hip/hip_runtime.h>
#include <hip/hip_bf16.h>
#include <cstdio>
#include <cstdint>
#include <cmath>

constexpr int DM = 1024, NB = 32, SEQ = 2048, CTXL = 256, BW = 512;
constexpr int ML = NB * SEQ;
constexpr int MC = NB * CTXL;
constexpr int MT = ML + MC;
constexpr int N_AB = 5 * BW;
constexpr int N_CD = 8 * BW;
constexpr int KVL = CTXL + SEQ;
constexpr float LN_EPS = 1e-5f;
constexpr float DN_ALPHA = 1.4142135623730951f;
constexpr float LAM_INIT = 0.35550906759096924f;
#define MK_N_LAUNCHES 10
namespace pg8 {
#define PG8_LAS __attribute__((address_space(3)))
typedef unsigned short bf16_t;
typedef short bf16x8 __attribute__((ext_vector_type(8)));
typedef float f32x4 __attribute__((ext_vector_type(4)));
typedef unsigned u32x4 __attribute__((ext_vector_type(4)));
constexpr int BM = 256, BK = 64, HALF = 128, HTB = HALF * BK * 2  , STAGE_BYTES = 8 * HTB, NXCD = 8, WGM = 8;

__host__ __device__ __forceinline__ int lds_byte(int r, int c) { const int st = (r >> 4) * 2 + (c >> 5), rr = r & 15, cc = c & 31, ob = rr * 64 + cc * 2; return st * 1024 + (ob ^ (((ob >> 9) & 1) << 5)); }
__host__ __device__ __forceinline__ void stage_rc(int b, int& R, int& C) { const int st = b / 1024, sb = b % 1024, swz = sb ^ (((sb >> 9) & 1) << 5); R = (st >> 1) * 16 + swz / 64; C = (st & 1) * 32 + (swz % 64) / 2; }
__host__ __device__ __forceinline__ int perm32(int rho) { const int n = rho >> 4, i = rho & 15; return 8 * (i >> 2) + 4 * n + (i & 3); }

struct Unit { int pm, pn; };
struct Gemm { const bf16_t* A; const bf16_t* Bt; int M, N, K; };

struct StaticOrder {
    int nM, nN, nwg, G, c;
    __host__ __device__ void init(int M, int N, int G_, int c_) { nM = M / BM; nN = N / BM; nwg = nM * nN; G = G_; c = c_; }
    __host__ __device__ bool next(int i, Unit& u) const {
        const long L = (long)i * G + c; if (L >= nwg) return false;
        int wgid = (int)L; { const int q = nwg / NXCD, r = nwg % NXCD, xcd = wgid % NXCD, off = wgid / NXCD; wgid = (xcd < r ? xcd * (q + 1) : r * (q + 1) + (xcd - r) * q) + off; }
        const int nig = WGM * nN, gid = wgid / nig, fm = gid * WGM, gsz = (nM - fm) < WGM ? (nM - fm) : WGM;
        u.pm = fm + ((wgid % nig) % gsz); u.pn = (wgid % nig) / gsz; return true;
    }
    __device__ __forceinline__ void a_ready(const Unit&) const {}
    __device__ __forceinline__ void done(const Unit&) const {}
};

__device__ __forceinline__ unsigned cvt_pk_bf16(float lo, float hi) { unsigned r; asm volatile("v_cvt_pk_bf16_f32 %0, %1, %2" : "=v"(r) : "v"(lo), "v"(hi)); return r; }
typedef float f32x2 __attribute__((ext_vector_type(2)));
__device__ __forceinline__ f32x2 gelu_pk(f32x2 v) {
    const f32x2 av = __builtin_elementwise_abs(v), d = av * 0.2316418882f + 1.0f;
    f32x2 t; t.x = __builtin_amdgcn_rcpf(d.x); t.y = __builtin_amdgcn_rcpf(d.y);
    f32x2 q = t * 0.5307027145f + (-0.7265760135f); q = q * t + 0.7107068705f; q = q * t + (-0.142248368f); q = q * t + 0.127414796f; q = q * t;
    const f32x2 s = (v * v) * (-0.72134752044f);
    f32x2 e; e.x = __builtin_amdgcn_exp2f(s.x); e.y = __builtin_amdgcn_exp2f(s.y);
    const f32x2 m = v * (q * e), r = v - m;
    f32x2 o; o.x = v.x < 0.f ? m.x : r.x; o.y = v.y < 0.f ? m.y : r.y; return o;
}

template <int ACT  > struct EpiBf16 {
    static constexpr bool PERM = true, AFTER_DRAIN = false; static_assert(ACT == 0 || ACT == 1, "EpiBf16: ACT is 0 (none) or 1 (gelu_pk)");
    bf16_t* O; int ldc; const float* bias; int split_cols; size_t split_stride; float scale0;
    __device__ __forceinline__ void operator()(const f32x4 (&acc)[2][2][4][2], const Unit& u, int wr, int wc, int fr, int fq) const {
        const int row0 = u.pm * BM + wr * 64 + fr; int colt = u.pn * BM; bf16_t* base = O;
        float sc = 1.f; if (split_cols) { const int t = colt / split_cols; base += (size_t)t * split_stride; colt -= t * split_cols; if (t == 0) sc = scale0; }
        const int col0 = colt + wc * 32 + 8 * fq, bcol0 = u.pn * BM + wc * 32 + 8 * fq;
        f32x4 bv[2][2];
#pragma unroll
        for (int bj = 0; bj < 2; ++bj)
#pragma unroll
            for (int n = 0; n < 2; ++n) bv[bj][n] = bias ? *(const f32x4*)(bias + bcol0 + bj * HALF + 4 * n) : (f32x4){0.f, 0.f, 0.f, 0.f};
#pragma unroll
        for (int ai = 0; ai < 2; ++ai)
#pragma unroll
            for (int m = 0; m < 4; ++m) { bf16_t* rowp = base + (size_t)(row0 + ai * HALF + m * 16) * ldc + col0;
#pragma unroll
                for (int bj = 0; bj < 2; ++bj) { f32x4 v0 = acc[ai][bj][m][0] + bv[bj][0], v1 = acc[ai][bj][m][1] + bv[bj][1];
                    if (ACT == 1) { f32x2 a = gelu_pk((f32x2){v0[0], v0[1]}), b = gelu_pk((f32x2){v0[2], v0[3]}), c = gelu_pk((f32x2){v1[0], v1[1]}), d = gelu_pk((f32x2){v1[2], v1[3]});
                        v0 = (f32x4){a.x, a.y, b.x, b.y}; v1 = (f32x4){c.x, c.y, d.x, d.y}; }
                    v0 = v0 * sc; v1 = v1 * sc; u32x4 w; w.x = cvt_pk_bf16(v0[0], v0[1]); w.y = cvt_pk_bf16(v0[2], v0[3]); w.z = cvt_pk_bf16(v1[0], v1[1]); w.w = cvt_pk_bf16(v1[2], v1[3]);
                    *(u32x4*)(rowp + bj * HALF) = w; } }
    }
};
__device__ __forceinline__ float silu_f(float v) { return v * __builtin_amdgcn_rcpf(1.f + __expf(-v)); }
__device__ __forceinline__ float gelu_f(float v) { const float u2 = 1.5957691216057308f * (v + 0.044715f * v * v * v); return v * __builtin_amdgcn_rcpf(1.f + __expf(-u2)); }
__device__ __forceinline__ float bf_lo(unsigned w) { return __uint_as_float(w << 16); }
__device__ __forceinline__ float bf_hi(unsigned w) { return __uint_as_float(w & 0xffff0000u); }

struct EpiAct1 {
    static constexpr bool PERM = true, AFTER_DRAIN = false;
    bf16_t* O;
    __device__ __forceinline__ void operator()(const f32x4 (&acc)[2][2][4][2], const Unit& u, int wr, int wc, int fr, int fq) const {
        const int act = (u.pn < 2) ? 0 : (u.pn < 4) ? 1 : (u.pn < 8) ? 2 : 1;
        const int row0 = u.pm * BM + wr * 64 + fr, col0 = u.pn * BM + wc * 32 + 8 * fq;
#pragma unroll
        for (int ai = 0; ai < 2; ++ai)
#pragma unroll
            for (int m = 0; m < 4; ++m) { bf16_t* rowp = O + (size_t)(row0 + ai * HALF + m * 16) * N_AB + col0;
#pragma unroll
                for (int bj = 0; bj < 2; ++bj) { f32x4 v0 = acc[ai][bj][m][0], v1 = acc[ai][bj][m][1];
                    if (act == 1) {
#pragma unroll
                        for (int e = 0; e < 4; ++e) { v0[e] = silu_f(v0[e]); v1[e] = silu_f(v1[e]); }
                    } else if (act == 2) {
#pragma unroll
                        for (int e = 0; e < 4; ++e) { v0[e] = gelu_f(v0[e]); v1[e] = gelu_f(v1[e]); }
                    }
                    u32x4 w; w.x = cvt_pk_bf16(v0[0], v0[1]); w.y = cvt_pk_bf16(v0[2], v0[3]); w.z = cvt_pk_bf16(v1[0], v1[1]); w.w = cvt_pk_bf16(v1[2], v1[3]);
                    *(u32x4*)(rowp + bj * HALF) = w; } }
    }
};

template <bool LAST> struct EpiZ {
    static constexpr bool PERM = true, AFTER_DRAIN = false;
    const float* xres; const float* cres; const bf16_t* xb; const float* mod; bf16_t* Zb; float* Zf; float* stats;
    __device__ __forceinline__ void operator()(const f32x4 (&acc)[2][2][4][2], const Unit& u, int wr, int wc, int fr, int fq) const {
        const int rowt = u.pm * BM;
        const int bidx = (rowt < ML) ? (rowt / SEQ) : 32;
        const float* gate = mod + bidx * 3072 + 2048;
        const int row0 = rowt + wr * 64 + fr, col0 = u.pn * BM + wc * 32 + 8 * fq;
        f32x4 gv[2][2];
#pragma unroll
        for (int bj = 0; bj < 2; ++bj)
#pragma unroll
            for (int n = 0; n < 2; ++n) gv[bj][n] = *(const f32x4*)(gate + col0 + bj * HALF + 4 * n);
#pragma unroll
        for (int ai = 0; ai < 2; ++ai)
#pragma unroll
            for (int m = 0; m < 4; ++m) { const int row = row0 + ai * HALF + m * 16; float s = 0.f, q = 0.f;
#pragma unroll
                for (int bj = 0; bj < 2; ++bj) { f32x4 r0, r1; const int col = col0 + bj * HALF;
                    if constexpr (!LAST) { const float* rp = (row < ML) ? xres + (size_t)row * DM : cres + (size_t)(row - ML) * DM; r0 = *(const f32x4*)(rp + col); r1 = *(const f32x4*)(rp + col + 4); }
                    else { const u32x4 rb = *(const u32x4*)(xb + (size_t)row * DM + col); r0 = (f32x4){bf_lo(rb.x), bf_hi(rb.x), bf_lo(rb.y), bf_hi(rb.y)}; r1 = (f32x4){bf_lo(rb.z), bf_hi(rb.z), bf_lo(rb.w), bf_hi(rb.w)}; }
                    const f32x4 z0 = r0 * DN_ALPHA + gv[bj][0] * acc[ai][bj][m][0], z1 = r1 * DN_ALPHA + gv[bj][1] * acc[ai][bj][m][1];
                    s += (z0[0] + z0[1]) + (z0[2] + z0[3]) + (z1[0] + z1[1]) + (z1[2] + z1[3]);
                    q += (z0[0] * z0[0] + z0[1] * z0[1]) + (z0[2] * z0[2] + z0[3] * z0[3]) + (z1[0] * z1[0] + z1[1] * z1[1]) + (z1[2] * z1[2] + z1[3] * z1[3]);
                    if constexpr (!LAST) { u32x4 w; w.x = cvt_pk_bf16(z0[0], z0[1]); w.y = cvt_pk_bf16(z0[2], z0[3]); w.z = cvt_pk_bf16(z1[0], z1[1]); w.w = cvt_pk_bf16(z1[2], z1[3]);
                        *(u32x4*)(Zb + (size_t)row * DM + col) = w; }
                    else { *(f32x4*)(Zf + (size_t)row * DM + col) = z0; *(f32x4*)(Zf + (size_t)row * DM + col + 4) = z1; } }
                s += __shfl_xor(s, 16); s += __shfl_xor(s, 32); q += __shfl_xor(q, 16); q += __shfl_xor(q, 32);
                if (fq == 0) { typedef float f32x2v __attribute__((ext_vector_type(2))); *(f32x2v*)(stats + ((size_t)row * 16 + u.pn * 4 + wc) * 2) = (f32x2v){s, q}; } }
    }
};

struct EpiP1 {
    static constexpr bool PERM = true, AFTER_DRAIN = false;
    bf16_t *P1a, *Qb, *KV, *Gb; const float *ropec, *ropes;
    __device__ __forceinline__ void operator()(const f32x4 (&acc)[2][2][4][2], const Unit& u, int wr, int wc, int fr, int fq) const {
        const int pn = u.pn, rowt = u.pm * BM; const bool isctx = rowt >= ML;
        bf16_t* base; int ld; int colt; long rowadd = 0;
        if (pn < 8) { base = P1a; ld = 2048; colt = pn * BM; }
        else if (pn < 10) { base = Qb; ld = 512; colt = (pn - 8) * BM; }
        else if (pn < 14) { base = KV; ld = 1024; colt = (pn - 10) * BM;
            if (isctx) { const int bb = (rowt - ML) / CTXL; rowadd = (long)bb * SEQ - ML; } else { const int bb = rowt / SEQ; rowadd = (long)(bb + 1) * CTXL; } }
        else { base = Gb; ld = 512; colt = (pn - 14) * BM; }
        const bool do_silu = (pn == 6 || pn == 7 || pn >= 14);
        const bool do_rope = (pn == 8 || pn == 9 || ((pn == 10 || pn == 11) && !isctx));
        const int row0 = rowt + wr * 64 + fr, col0 = colt + wc * 32 + 8 * fq;
        const float sgn = (fq >> 1) ? 1.f : -1.f;
#pragma unroll
        for (int ai = 0; ai < 2; ++ai)
#pragma unroll
            for (int m = 0; m < 4; ++m) { const int row = row0 + ai * HALF + m * 16;
                bf16_t* rowp = base + (size_t)((long)row + rowadd) * ld + col0;
                f32x4 c0, c1, s0, s1;
                if (do_rope) { const int t = row & (SEQ - 1); const int pos = (wc & 1) ? (t & 63) : (t >> 6); const int ti = pos * 16 + 8 * (fq & 1);
                    c0 = *(const f32x4*)(ropec + ti); c1 = *(const f32x4*)(ropec + ti + 4); s0 = *(const f32x4*)(ropes + ti); s1 = *(const f32x4*)(ropes + ti + 4); }
#pragma unroll
                for (int bj = 0; bj < 2; ++bj) { f32x4 v0 = acc[ai][bj][m][0], v1 = acc[ai][bj][m][1];
                    if (do_silu) {
#pragma unroll
                        for (int e = 0; e < 4; ++e) { v0[e] = silu_f(v0[e]); v1[e] = silu_f(v1[e]); }
                    }
                    if (do_rope) { f32x4 p0, p1;
#pragma unroll
                        for (int e = 0; e < 4; ++e) { p0[e] = __shfl_xor(v0[e], 32); p1[e] = __shfl_xor(v1[e], 32); }
                        v0 = v0 * c0 + (p0 * s0) * sgn; v1 = v1 * c1 + (p1 * s1) * sgn; }
                    u32x4 w; w.x = cvt_pk_bf16(v0[0], v0[1]); w.y = cvt_pk_bf16(v0[2], v0[3]); w.z = cvt_pk_bf16(v1[0], v1[1]); w.w = cvt_pk_bf16(v1[2], v1[3]);
                    *(u32x4*)(rowp + bj * HALF) = w; } }
    }
};
template <class Epi, class Sched, bool ALIGN_EPI = false, bool SP2 = false>
__device__ __forceinline__ void gemm_phase(PG8_LAS unsigned char* lds, const Gemm g, const Sched& S, const Epi& E) {
    const int tid = threadIdx.x, wid = __builtin_amdgcn_readfirstlane(tid >> 6), lane = tid & 63, wr = wid >> 2, wc = wid & 3, fr = lane & 15, fq = lane >> 4;
    const int K = g.K, nt = K / BK;
    unsigned voffA[2], voffB[2];
#pragma unroll
    for (int i = 0; i < 2; ++i) { int R, C; stage_rc(tid * 16 + i * 8192, R, C); const int Rb = Epi::PERM ? ((R & ~31) + perm32(R & 31)) : R;
        voffA[i] = (unsigned)(R * K + C) * 2u; voffB[i] = (unsigned)(Rb * K + C) * 2u; }
    const size_t kstep = (size_t)(BK * 2);
    const size_t hstep = (size_t)HALF * K * 2;
    const size_t tstep = 2 * hstep;
    const unsigned ldsw = (unsigned)wid * 1024u;
    const int aoff = lds_byte(wr * 64 + fr, fq * 8), boff = lds_byte(wc * 32 + fr, fq * 8);
#define PG8_SA(b, h) (((b) * 2 + (h)) * HTB)
#define PG8_SB(b, h) ((4 + (b) * 2 + (h)) * HTB)
#define PG8_STAGE(bufoff, gbase, voff) do { _Pragma("unroll") for (int _i = 0; _i < 2; ++_i) \
        __builtin_amdgcn_global_load_lds((const unsigned*)((const char*)(gbase) + (voff)[_i]), (PG8_LAS unsigned*)(lds + (bufoff) + ldsw + _i * 8192), 16, 0, 0); } while (0)
#define PG8_LDA(dst, b, h) do { _Pragma("unroll") for (int m = 0; m < 4; ++m) _Pragma("unroll") for (int k = 0; k < 2; ++k) dst[m][k] = *(const PG8_LAS bf16x8*)(lds + PG8_SA(b, h) + aoff + m * 2048 + k * 1024); } while (0)
#define PG8_LDB(dst, b, h) do { _Pragma("unroll") for (int n = 0; n < 2; ++n) _Pragma("unroll") for (int k = 0; k < 2; ++k) dst[n][k] = *(const PG8_LAS bf16x8*)(lds + PG8_SB(b, h) + boff + n * 2048 + k * 1024); } while (0)
#define PG8_MMA(ai, bj, At, Bt) do { __builtin_amdgcn_s_setprio(1); _Pragma("unroll") for (int m = 0; m < 4; ++m) _Pragma("unroll") for (int n = 0; n < 2; ++n) _Pragma("unroll") for (int k = 0; k < 2; ++k) \
        acc[ai][bj][m][n] = __builtin_amdgcn_mfma_f32_16x16x32_bf16(Bt[n][k], At[m][k], acc[ai][bj][m][n], 0, 0, 0); __builtin_amdgcn_s_setprio(0); } while (0)
#define PG8_WAIT_V(n) asm volatile("s_waitcnt vmcnt(" #n ")" ::: "memory")
#define PG8_WAIT_L(n) asm volatile("s_waitcnt lgkmcnt(" #n ")" ::: "memory")
#define PG8_BAR __builtin_amdgcn_s_barrier()
#define PG8_SCHED __builtin_amdgcn_sched_barrier(0)
    Unit cur, nxt; int ui = 0;
    if (!S.next(0, cur)) return;
    f32x4 acc[2][2][4][2];
#pragma unroll
    for (int a = 0; a < 2; ++a)
#pragma unroll
        for (int b = 0; b < 2; ++b)
#pragma unroll
            for (int m = 0; m < 4; ++m)
#pragma unroll
                for (int n = 0; n < 2; ++n) acc[a][b][m][n] = (f32x4){0.f, 0.f, 0.f, 0.f};
    bf16x8 At[4][2], B0[2][2], B1[2][2];
    const char* cA = (const char*)g.A + (size_t)cur.pm * tstep; const char* cB = (const char*)g.Bt + (size_t)cur.pn * tstep;
    S.a_ready(cur);
    if constexpr (SP2) {
        PG8_STAGE(PG8_SB(0, 0), cB, voffB); PG8_STAGE(PG8_SB(0, 1), cB + hstep, voffB); PG8_STAGE(PG8_SA(0, 0), cA, voffA); PG8_STAGE(PG8_SA(0, 1), cA + hstep, voffA);
        if (wr == 1) PG8_BAR;
        PG8_WAIT_V(2); PG8_BAR;
        PG8_STAGE(PG8_SB(1, 0), cB + kstep, voffB); PG8_STAGE(PG8_SA(1, 0), cA + kstep, voffA); PG8_STAGE(PG8_SB(1, 1), cB + hstep + kstep, voffB);
        PG8_WAIT_V(6); PG8_BAR;
    } else {
        PG8_STAGE(PG8_SB(0, 0), cB, voffB); PG8_STAGE(PG8_SA(0, 0), cA, voffA); PG8_STAGE(PG8_SB(0, 1), cB + hstep, voffB); PG8_STAGE(PG8_SA(0, 1), cA + hstep, voffA);
        if (wr == 1) PG8_BAR;
        PG8_WAIT_V(4); PG8_BAR;
        PG8_STAGE(PG8_SB(1, 0), cB + kstep, voffB); PG8_STAGE(PG8_SA(1, 0), cA + kstep, voffA); PG8_STAGE(PG8_SB(1, 1), cB + hstep + kstep, voffB);
        PG8_WAIT_V(6); PG8_BAR;
    }
    for (;;) {
        const bool has_next = S.next(ui + 1, nxt);
        const char* nA = has_next ? (const char*)g.A + (size_t)nxt.pm * tstep : cA; const char* nB = has_next ? (const char*)g.Bt + (size_t)nxt.pn * tstep : cB;
        for (int t = 0; t < nt; t += 2) {
            const bool last = (t == nt - 2);
            const char* a1 = cA + (size_t)(t + 1) * kstep;
            const char* a2 = last ? nA : cA + (size_t)(t + 2) * kstep; const char* b2 = last ? nB : cB + (size_t)(t + 2) * kstep;
            const char* a3 = a2 + kstep; const char* b3 = b2 + kstep;
            if (last && has_next) S.a_ready(nxt);
            if constexpr (SP2) {
            PG8_LDB(B0, 0, 0); PG8_LDB(B1, 0, 1); PG8_SCHED; PG8_LDA(At, 0, 0); PG8_STAGE(PG8_SA(1, 1), a1 + hstep, voffA);
            PG8_WAIT_V(8); PG8_WAIT_L(0); PG8_BAR; PG8_MMA(0, 0, At, B0); PG8_MMA(0, 1, At, B1); PG8_BAR; PG8_SCHED;
            PG8_LDA(At, 0, 1); PG8_STAGE(PG8_SB(0, 0), b2, voffB); PG8_STAGE(PG8_SB(0, 1), b2 + hstep, voffB); PG8_STAGE(PG8_SA(0, 0), a2, voffA);
            PG8_WAIT_V(8); PG8_WAIT_L(0); PG8_BAR; PG8_MMA(1, 0, At, B0); PG8_MMA(1, 1, At, B1); PG8_BAR; PG8_SCHED;
            PG8_LDB(B0, 1, 0); PG8_LDB(B1, 1, 1); PG8_SCHED; PG8_LDA(At, 1, 0); PG8_STAGE(PG8_SA(0, 1), a2 + hstep, voffA);
            PG8_WAIT_V(8); PG8_WAIT_L(0); PG8_BAR; PG8_MMA(0, 0, At, B0); PG8_MMA(0, 1, At, B1); PG8_BAR; PG8_SCHED;
            PG8_LDA(At, 1, 1); PG8_STAGE(PG8_SB(1, 0), b3, voffB); PG8_STAGE(PG8_SB(1, 1), b3 + hstep, voffB); PG8_STAGE(PG8_SA(1, 0), a3, voffA);
            PG8_WAIT_V(8); PG8_WAIT_L(0); PG8_BAR; PG8_MMA(1, 0, At, B0); PG8_MMA(1, 1, At, B1); PG8_BAR; PG8_SCHED;
            } else {
            PG8_LDB(B0, 0, 0); PG8_SCHED; PG8_LDA(At, 0, 0); PG8_STAGE(PG8_SA(1, 1), a1 + hstep, voffA);
            PG8_WAIT_L(8); PG8_BAR; PG8_WAIT_L(0); PG8_MMA(0, 0, At, B0); PG8_BAR; PG8_SCHED;
            PG8_LDB(B1, 0, 1); PG8_STAGE(PG8_SB(0, 0), b2, voffB);
            PG8_BAR; PG8_WAIT_L(0); PG8_MMA(0, 1, At, B1); PG8_BAR;
            PG8_LDA(At, 0, 1); PG8_STAGE(PG8_SA(0, 0), a2, voffA);
            PG8_BAR; PG8_WAIT_L(0); PG8_MMA(1, 0, At, B0); PG8_BAR; PG8_SCHED;
            PG8_STAGE(PG8_SB(0, 1), b2 + hstep, voffB);
            PG8_WAIT_V(6); PG8_BAR; PG8_MMA(1, 1, At, B1); PG8_BAR;
            PG8_LDB(B0, 1, 0); PG8_SCHED; PG8_LDA(At, 1, 0); PG8_STAGE(PG8_SA(0, 1), a2 + hstep, voffA);
            PG8_WAIT_L(8); PG8_BAR; PG8_WAIT_L(0); PG8_MMA(0, 0, At, B0); PG8_BAR; PG8_SCHED;
            PG8_LDB(B1, 1, 1); PG8_STAGE(PG8_SB(1, 0), b3, voffB);
            PG8_BAR; PG8_WAIT_L(0); PG8_MMA(0, 1, At, B1); PG8_BAR;
            PG8_LDA(At, 1, 1); PG8_STAGE(PG8_SA(1, 0), a3, voffA);
            PG8_BAR; PG8_WAIT_L(0); PG8_MMA(1, 0, At, B0); PG8_BAR; PG8_SCHED;
            PG8_STAGE(PG8_SB(1, 1), b3 + hstep, voffB);
            PG8_WAIT_V(6); PG8_BAR; PG8_MMA(1, 1, At, B1); PG8_BAR;
            }
        }
        if constexpr (ALIGN_EPI) { if (wr == 0) PG8_BAR; }
        if constexpr (!Epi::AFTER_DRAIN) { E(acc, cur, wr, wc, fr, fq); S.done(cur); }
        if (!has_next) break;
#pragma unroll
        for (int a = 0; a < 2; ++a)
#pragma unroll
            for (int b = 0; b < 2; ++b)
#pragma unroll
                for (int m = 0; m < 4; ++m)
#pragma unroll
                    for (int n = 0; n < 2; ++n) acc[a][b][m][n] = (f32x4){0.f, 0.f, 0.f, 0.f};
        cur = nxt; cA = nA; cB = nB; ++ui;
        if constexpr (ALIGN_EPI) { if (wr == 1) PG8_BAR; }
    }
    PG8_WAIT_V(0);
    if constexpr (!ALIGN_EPI) { if (wr == 0) PG8_BAR; }
    PG8_BAR;
    if constexpr (Epi::AFTER_DRAIN) { E.fused(acc, cur, wr, wc, fr, fq, lds, wid, lane); S.done(cur); }
#undef PG8_SA
#undef PG8_SB
#undef PG8_STAGE
#undef PG8_LDA
#undef PG8_LDB
#undef PG8_MMA
#undef PG8_WAIT_V
#undef PG8_WAIT_L
#undef PG8_BAR
#undef PG8_SCHED
}
}
namespace att {
using bf16 = __hip_bfloat16;
constexpr int KVBLK = 64;
constexpr float SCALE = 0.125f;
constexpr float THR = 8.f;
using bf16x8 = __attribute__((ext_vector_type(8))) short;
using s16x4  = __attribute__((ext_vector_type(4))) short;
using f32x16 = __attribute__((ext_vector_type(16))) float;
using f32x8  = __attribute__((ext_vector_type(8))) float;
using u32x4  = __attribute__((ext_vector_type(4))) unsigned;
#define KSWZ(row, colB) ((row) * 256 + ((colB) ^ (((row) & 7) << 4)))
#define SBAR() __builtin_amdgcn_sched_barrier(0)
__device__ __forceinline__ int crow(int r, int hi) { return (r & 3) + 8 * (r >> 2) + 4 * hi; }
__device__ __forceinline__ unsigned cvtpk(float lo, float hi) {
  unsigned r; asm volatile("v_cvt_pk_bf16_f32 %0, %1, %2" : "=v"(r) : "v"(lo), "v"(hi)); return r;
}
template <typename TIn> struct Stage;
template <> struct Stage<bf16>  { using T = bf16x8;
  __device__ static __forceinline__ T ld8(const bf16* p) { return *reinterpret_cast<const bf16x8*>(p); }
  __device__ static __forceinline__ bf16x8 tobf(T x) { return x; } };
template <> struct Stage<float> { using T = f32x8;
  __device__ static __forceinline__ T ld8(const float* p) { return *reinterpret_cast<const f32x8*>(p); }
  __device__ static __forceinline__ bf16x8 tobf(T x) {
    u32x4 w = {cvtpk(x[0], x[1]), cvtpk(x[2], x[3]), cvtpk(x[4], x[5]), cvtpk(x[6], x[7])}; return *reinterpret_cast<bf16x8*>(&w); } };

__device__ __forceinline__ void partialSM(f32x16& p0, f32x16& p1, float& m_reg, float& mn, float& alpha) {
  constexpr float C = SCALE * 1.4426950408889634f;
  float pmax = p0[0]; for (int r = 1; r < 16; ++r) pmax = fmaxf(pmax, p0[r]); for (int r = 0; r < 16; ++r) pmax = fmaxf(pmax, p1[r]);
  { auto rr = __builtin_amdgcn_permlane32_swap(__float_as_uint(pmax), __float_as_uint(pmax), false, false);
    pmax = fmaxf(__uint_as_float(rr[0]), __uint_as_float(rr[1])); }
  if (__builtin_expect(__all(pmax - m_reg <= THR / SCALE), 1)) { mn = m_reg; alpha = 1.f; }
  else { mn = fmaxf(m_reg, pmax); alpha = __builtin_amdgcn_exp2f((m_reg - mn) * C); m_reg = mn; }
  float mnC = -mn * C;
  for (int r = 0; r < 16; ++r) p0[r] = fmaf(p0[r], C, mnC); for (int r = 0; r < 16; ++r) p1[r] = fmaf(p1[r], C, mnC);
  for (int r = 0; r < 16; ++r) p0[r] = __builtin_amdgcn_exp2f(p0[r]);
}
__device__ __forceinline__ void finishSM(f32x16& p0, f32x16& p1, float alpha, float& l_reg, bf16x8& pa0, bf16x8& pa1, bf16x8& pa2, bf16x8& pa3) {
  for (int r = 0; r < 16; ++r) p1[r] = __builtin_amdgcn_exp2f(p1[r]);
  float ps = 0; for (int r = 0; r < 16; ++r) ps += p0[r]; for (int r = 0; r < 16; ++r) ps += p1[r];
  { auto rr = __builtin_amdgcn_permlane32_swap(__float_as_uint(ps), __float_as_uint(ps), false, false);
    ps = __uint_as_float(rr[0]) + __uint_as_float(rr[1]); }
  l_reg = l_reg * alpha + ps;
#define PK4(P, BASE, OUT) do { unsigned a0 = cvtpk(P[BASE + 0], P[BASE + 1]), a1 = cvtpk(P[BASE + 2], P[BASE + 3]);   \
    unsigned b0 = cvtpk(P[BASE + 4], P[BASE + 5]), b1 = cvtpk(P[BASE + 6], P[BASE + 7]);                              \
    auto r0 = __builtin_amdgcn_permlane32_swap(a0, b0, false, false); auto r1 = __builtin_amdgcn_permlane32_swap(a1, b1, false, false); \
    u32x4 w = {r0[0], r1[0], r0[1], r1[1]}; OUT = *reinterpret_cast<bf16x8*>(&w); } while (0)
  PK4(p0, 0, pa0); PK4(p0, 8, pa1); PK4(p1, 0, pa2); PK4(p1, 8, pa3);
#undef PK4
}
__device__ __forceinline__ void qkt(f32x16& p0, f32x16& p1, const bf16* Ks, const bf16x8* qr, int r32, int hi) {
  p0 = f32x16{}; p1 = f32x16{};
  for (int d0 = 0; d0 < 8; ++d0) { int cb = (d0 * 16 + hi * 8) * 2;
    bf16x8 b0 = *reinterpret_cast<const bf16x8*>((const char*)Ks + KSWZ(r32, cb));
    bf16x8 b1 = *reinterpret_cast<const bf16x8*>((const char*)Ks + KSWZ(32 + r32, cb));
    p0 = __builtin_amdgcn_mfma_f32_32x32x16_bf16(b0, qr[d0], p0, 0, 0, 0);
    p1 = __builtin_amdgcn_mfma_f32_32x32x16_bf16(b1, qr[d0], p1, 0, 0, 0); }
}
__device__ __forceinline__ int v_st(int k, int c) { const int kk = (k & ~0xC) | ((k & 4) << 1) | ((k & 8) >> 1); return ((kk >> 3) * 4 + (c >> 5)) * 512 + ((kk & 7) * 32 + (c & 31)) * 2; }
__device__ __forceinline__ int v_rd_base(int lane) { return ((lane & 3) << 3) | (((lane >> 2) & 3) << 6) | (((lane >> 4) & 1) << 5) | (((lane >> 5) & 1) << 8); }
constexpr int v_rd_off(int d0, int ks, int half) { return d0 * 512 + ks * 4096 + half * 2048; }
template <int OFF> __device__ __forceinline__ s16x4 tr_read(int vb) {
  s16x4 r; asm volatile("ds_read_b64_tr_b16 %0, %1 offset:%2" : "=&v"(r) : "v"(vb), "i"(OFF) : "memory"); return r;
}
template <int D0> __device__ __forceinline__ void pv_one(f32x16& od, int vb, bf16x8 pa0, bf16x8 pa1, bf16x8 pa2, bf16x8 pa3) {
  const s16x4 l0 = tr_read<v_rd_off(D0, 0, 0)>(vb), h0 = tr_read<v_rd_off(D0, 0, 1)>(vb), l1 = tr_read<v_rd_off(D0, 1, 0)>(vb), h1 = tr_read<v_rd_off(D0, 1, 1)>(vb);
  const s16x4 l2 = tr_read<v_rd_off(D0, 2, 0)>(vb), h2 = tr_read<v_rd_off(D0, 2, 1)>(vb), l3 = tr_read<v_rd_off(D0, 3, 0)>(vb), h3 = tr_read<v_rd_off(D0, 3, 1)>(vb);
  asm volatile("s_waitcnt lgkmcnt(0)" ::: "memory"); SBAR();
#define PK(L, H) (bf16x8){L[0], L[1], L[2], L[3], H[0], H[1], H[2], H[3]}
  od = __builtin_amdgcn_mfma_f32_32x32x16_bf16(pa0, PK(l0, h0), od, 0, 0, 0);
  od = __builtin_amdgcn_mfma_f32_32x32x16_bf16(pa1, PK(l1, h1), od, 0, 0, 0);
  od = __builtin_amdgcn_mfma_f32_32x32x16_bf16(pa2, PK(l2, h2), od, 0, 0, 0);
  od = __builtin_amdgcn_mfma_f32_32x32x16_bf16(pa3, PK(l3, h3), od, 0, 0, 0);
#undef PK
}
__device__ __forceinline__ void pv_d0(f32x16* o, int vb, bf16x8 pa0, bf16x8 pa1, bf16x8 pa2, bf16x8 pa3) {
  pv_one<0>(o[0], vb, pa0, pa1, pa2, pa3); pv_one<1>(o[1], vb, pa0, pa1, pa2, pa3); pv_one<2>(o[2], vb, pa0, pa1, pa2, pa3); pv_one<3>(o[3], vb, pa0, pa1, pa2, pa3);
}
constexpr int LDKV = 1024, LDQ = 512;
constexpr size_t SHM_V = 64 * 128 * 2, SHM_K = 64 * 128 * 2, SHM_ATTN = 2 * SHM_V + 2 * SHM_K + 8 * 64 * 4;
__device__ __forceinline__ void qkt64(f32x16& p0, f32x16& p1, const bf16* Ks, const bf16x8* qr, int r32, int hi, int mo) {
  p0 = f32x16{}; p1 = f32x16{};
#pragma unroll
  for (int d0 = 0; d0 < 4; ++d0) { int cb = (mo + d0 * 16 + hi * 8) * 2;
    bf16x8 b0 = *reinterpret_cast<const bf16x8*>((const char*)Ks + KSWZ(r32, cb));
    bf16x8 b1 = *reinterpret_cast<const bf16x8*>((const char*)Ks + KSWZ(32 + r32, cb));
    p0 = __builtin_amdgcn_mfma_f32_32x32x16_bf16(b0, qr[d0], p0, 0, 0, 0);
    p1 = __builtin_amdgcn_mfma_f32_32x32x16_bf16(b1, qr[d0], p1, 0, 0, 0); }
}
__device__ __forceinline__ void attn_unit(const bf16* __restrict__ Qb, const bf16* __restrict__ KVb, const bf16* __restrict__ Gb, bf16* __restrict__ Y1,
                                          const float* __restrict__ subg, float lam, int b, int h, int qb, char* lds) {
  using St = Stage<bf16>;
  const int tid = threadIdx.x, wid = tid >> 6, lane = tid & 63, r32 = lane & 31, hi = lane >> 5;
  const int rg = wid >> 1, mc = wid & 1, mo = mc * 64;
  bf16* V_lds = (bf16*)lds; bf16* K_lds = (bf16*)(lds + 2 * SHM_V);
  float* ws = (float*)(lds + 2 * SHM_V + 2 * SHM_K) + wid * 64; float* li_l = ws; float* al_l = ws + 32;
  float m_reg = -1e30f, l_reg = 0; f32x16 o[4] = {}; bf16x8 qr[4];
  const long qrow0 = (long)b * SEQ + qb * 128 + rg * 32;
  const bf16* Qw = Qb + (qrow0 + r32) * LDQ + h * 128 + mo + hi * 8;
#pragma unroll
  for (int d0 = 0; d0 < 4; ++d0) qr[d0] = St::ld8(Qw + d0 * 16);
  const bf16* Kh = KVb + (long)b * KVL * LDKV + h * 128; const bf16* Vh = Kh + 512;
  const int sr = tid >> 4, sc = (tid & 15) * 8, vst0 = v_st(sr, sc), vst1 = v_st(32 + sr, sc);
  const int vb0 = (int)(uintptr_t)V_lds + v_rd_base(lane);
  struct { typename St::T vs0, vs1, ks0, ks1; } sr_[2];
#define SLOAD(i, k0) do { sr_[i].vs0 = St::ld8(&Vh[(long)((k0) + sr) * LDKV + sc]); sr_[i].vs1 = St::ld8(&Vh[(long)((k0) + 32 + sr) * LDKV + sc]); \
    sr_[i].ks0 = St::ld8(&Kh[(long)((k0) + sr) * LDKV + sc]); sr_[i].ks1 = St::ld8(&Kh[(long)((k0) + 32 + sr) * LDKV + sc]); } while (0)
#define SWRITE(bb, i) do { *(bf16x8*)((char*)V_lds + (bb) * SHM_V + vst0) = St::tobf(sr_[i].vs0);          \
    *(bf16x8*)((char*)V_lds + (bb) * SHM_V + vst1) = St::tobf(sr_[i].vs1); int kc = sc * 2;               \
    *(bf16x8*)((char*)K_lds + (bb) * SHM_K + KSWZ(sr, kc)) = St::tobf(sr_[i].ks0);                       \
    *(bf16x8*)((char*)K_lds + (bb) * SHM_K + KSWZ(32 + sr, kc)) = St::tobf(sr_[i].ks1); } while (0)
#define SWAIT() asm volatile("s_waitcnt vmcnt(4)" ::: "memory")
#define RESC(a) do { if (__any((a) < 1.f)) { if (hi == 0) al_l[r32] = (a); asm volatile("s_waitcnt lgkmcnt(0)" ::: "memory"); \
    for (int d = 0; d < 4; ++d) for (int r = 0; r < 16; ++r) o[d][r] *= al_l[crow(r, hi)]; } } while (0)
  f32x16 pA0, pA1, pB0, pB1; float mnA, mnB, alA, alB; bf16x8 pa0, pa1, pa2, pa3; constexpr int NT = KVL / KVBLK;
  constexpr int SE = 0, SO = 1;
  SLOAD(SE, 0); asm volatile("s_waitcnt vmcnt(0)" ::: "memory"); SWRITE(0, SE); __syncthreads();
  qkt64(pA0, pA1, K_lds, qr, r32, hi, mo); partialSM(pA0, pA1, m_reg, mnA, alA);
  SLOAD(SO, KVBLK); SLOAD(SE, 2 * KVBLK);
  SWAIT(); SWRITE(1, SO); __syncthreads();
  for (int j = 1; j + 1 < NT; j += 2) {
    SBAR(); qkt64(pB0, pB1, (bf16*)((char*)K_lds + SHM_K), qr, r32, hi, mo);
    finishSM(pA0, pA1, alA, l_reg, pa0, pa1, pa2, pa3); SBAR();
    SLOAD(SO, (j + 2) * KVBLK); SBAR();
    pv_d0(o, vb0, pa0, pa1, pa2, pa3); partialSM(pB0, pB1, m_reg, mnB, alB);
    __syncthreads(); SWAIT(); SWRITE(0, SE);
    RESC(alB); __syncthreads();
    SBAR(); qkt64(pA0, pA1, K_lds, qr, r32, hi, mo);
    finishSM(pB0, pB1, alB, l_reg, pa0, pa1, pa2, pa3); SBAR();
    if (j + 3 < NT) SLOAD(SE, (j + 3) * KVBLK); SBAR();
    pv_d0(o, vb0 + (int)SHM_V, pa0, pa1, pa2, pa3); partialSM(pA0, pA1, m_reg, mnA, alA);
    __syncthreads(); SWAIT(); SWRITE(1, SO);
    RESC(alA); __syncthreads();
  }
  SBAR(); qkt64(pB0, pB1, (bf16*)((char*)K_lds + SHM_K), qr, r32, hi, mo);
  finishSM(pA0, pA1, alA, l_reg, pa0, pa1, pa2, pa3); SBAR();
  pv_d0(o, vb0, pa0, pa1, pa2, pa3); partialSM(pB0, pB1, m_reg, mnB, alB);
  __syncthreads(); RESC(alB);
  finishSM(pB0, pB1, alB, l_reg, pa0, pa1, pa2, pa3); SBAR();
  pv_d0(o, vb0 + (int)SHM_V, pa0, pa1, pa2, pa3);
#undef SLOAD
#undef SWRITE
#undef SWAIT
#undef RESC
  if (hi == 0) li_l[r32] = l_reg; asm volatile("s_waitcnt lgkmcnt(0)" ::: "memory");
  float rli[16];
#pragma unroll
  for (int r = 0; r < 16; ++r) rli[r] = 1.0f / li_l[crow(r, hi)];
#pragma unroll
  for (int d0 = 0; d0 < 4; ++d0)
#pragma unroll
    for (int r = 0; r < 16; ++r) o[d0][r] *= rli[r];
  __syncthreads();
  float* xch = (float*)lds + rg * 4096;
  if (mc == 1) {
#pragma unroll
    for (int d0 = 0; d0 < 4; ++d0)
#pragma unroll
      for (int r = 0; r < 16; ++r) xch[(d0 * 16 + r) * 64 + lane] = o[d0][r];
  }
  __syncthreads();
  if (mc == 0) {
    float ss[16];
#pragma unroll
    for (int r = 0; r < 16; ++r) { float a = 0.f;
#pragma unroll
      for (int d0 = 0; d0 < 4; ++d0) { const float d = o[d0][r] - lam * xch[(d0 * 16 + r) * 64 + lane]; o[d0][r] = d; a += d * d; }
      ss[r] = a; }
#pragma unroll
    for (int off = 1; off < 32; off <<= 1)
#pragma unroll
      for (int r = 0; r < 16; ++r) ss[r] += __shfl_xor(ss[r], off);
    float sg[4];
#pragma unroll
    for (int d0 = 0; d0 < 4; ++d0) sg[d0] = subg[d0 * 32 + r32] * (1.0f - LAM_INIT);
#pragma unroll
    for (int r = 0; r < 16; ++r) { const float rs = 1.0f / sqrtf(ss[r] * (1.0f / 128.0f) + LN_EPS); const long row = qrow0 + crow(r, hi);
#pragma unroll
      for (int d0 = 0; d0 < 4; ++d0) { const int col = h * 128 + d0 * 32 + r32; const float g = __bfloat162float(Gb[row * 512 + col]);
        Y1[row * 1024 + 512 + col] = __float2bfloat16(o[d0][r] * rs * sg[d0] * g); } }
  }
  __syncthreads();
}
#undef SBAR
}
#define GAS __attribute__((address_space(1)))
#define LAS __attribute__((address_space(3)))
typedef unsigned short bf16;
typedef unsigned v4u __attribute__((ext_vector_type(4)));
typedef float f32x4 __attribute__((ext_vector_type(4)));
typedef short bf16x8 __attribute__((ext_vector_type(8)));
typedef GAS unsigned gu32;
typedef GAS unsigned long long gu64;
#define RLX_AGENT __ATOMIC_RELAXED, __HIP_MEMORY_SCOPE_AGENT
#define LDS_WAIT() asm volatile("s_waitcnt lgkmcnt(0)" ::: "memory")
#define VM_WAIT() asm volatile("s_waitcnt vmcnt(0)" ::: "memory")
__device__ __forceinline__ unsigned long long rt() { return __builtin_amdgcn_s_memrealtime(); }
__device__ __forceinline__ unsigned f2bf(float f) { unsigned u = __builtin_bit_cast(unsigned, f); return (u + 0x7fffu + ((u >> 16) & 1u)) >> 16; }
__device__ __forceinline__ unsigned pk2(float lo, float hi) { return f2bf(lo) | (f2bf(hi) << 16); }
#define XB_TMO      128
#define XB_XCNT(j)  (256  + 64 * (j))
#define XB_XSUB(j)  (1280 + 64 * (j))
#define XB_XGEN(j)  (2304 + 64 * (j))
#define XB_TOP      3328
#define XB_TOPGEN   3392
#define XCD_BAR_WORDS 3456
#define XB_SPIN_CAP (1u << 18)

__device__ __forceinline__ unsigned xb_ld(unsigned* p)              { return __hip_atomic_load(p, __ATOMIC_RELAXED, __HIP_MEMORY_SCOPE_AGENT); }
__device__ __forceinline__ unsigned xb_add(unsigned* p, unsigned v) { return __hip_atomic_fetch_add(p, v, __ATOMIC_RELAXED, __HIP_MEMORY_SCOPE_AGENT); }
__device__ __forceinline__ unsigned xb_xcc_id() { return (unsigned)__builtin_amdgcn_s_getreg((3 << 11) | 20) & 0xFu; }
#define XB_SPIN(cond, bar) do { unsigned _sp = 0; while (cond) { __builtin_amdgcn_s_sleep(1); \
    if ((++_sp & 255u) == 0u) { if (xb_ld(&(bar)[XB_TMO])) break; if (_sp > XB_SPIN_CAP) { atomicAdd(&(bar)[XB_TMO], 1u); break; } } } } while (0)

struct XcdBarrier {
    unsigned* bar; unsigned x;
    volatile LAS unsigned* st;
};

__device__ __forceinline__ XcdBarrier xcd_barrier_post(unsigned* bar, volatile LAS unsigned* st) {
    XcdBarrier b; b.bar = bar; b.x = xb_xcc_id(); b.st = st;
    if (threadIdx.x == 0) (void)xb_add(&bar[XB_XCNT(b.x)], 1u);
    return b;
}
__device__ __forceinline__ void xcd_barrier_complete(unsigned* bar, unsigned x, unsigned& nloc, unsigned& nx) {
    const unsigned G = gridDim.x * gridDim.y * gridDim.z;
    unsigned sum, cnt, mine, sp = 0u;
    for (;;) {
        sum = 0u; cnt = 0u; mine = 0u;
#pragma unroll
        for (unsigned j = 0; j < 16; ++j) { const unsigned c = xb_ld(&bar[XB_XCNT(j)]); sum += c; cnt += (c > 0u) ? 1u : 0u; mine = (j == x) ? c : mine; }
        if (sum == G) break;
        __builtin_amdgcn_s_sleep(1);
        if ((++sp & 255u) == 0u) { if (xb_ld(&bar[XB_TMO])) break; if (sp > XB_SPIN_CAP) { atomicAdd(&bar[XB_TMO], 1u); break; } }
    }
    nloc = mine > 0u ? mine : 1u; nx = cnt > 0u ? cnt : 1u;
}

__device__ __forceinline__ void xcd_barrier(const XcdBarrier& b) {
    asm volatile("s_waitcnt vmcnt(0)" ::: "memory");
    __syncthreads();
    if (threadIdx.x == 0) {
        unsigned* bar = b.bar;
        __builtin_amdgcn_s_waitcnt(0);
        unsigned nloc = b.st[0], nx = b.st[1];
        if (nloc == 0u) { xcd_barrier_complete(bar, b.x, nloc, nx); b.st[0] = nloc; b.st[1] = nx; }
        const unsigned old = xb_add(&bar[XB_XSUB(b.x)], 1u);
        const unsigned gen = old / nloc;
        if (old + 1u == (gen + 1u) * nloc) {
            __builtin_amdgcn_fence(__ATOMIC_RELEASE, "agent");
            asm volatile("s_waitcnt vmcnt(0)" ::: "memory");
            const unsigned og = xb_add(&bar[XB_TOP], 1u);
            const unsigned tg = og / nx;
            if (og + 1u == (tg + 1u) * nx) xb_add(&bar[XB_TOPGEN], 1u);
            else XB_SPIN(xb_ld(&bar[XB_TOPGEN]) == tg, bar);
            __builtin_amdgcn_fence(__ATOMIC_ACQUIRE, "agent");
            xb_add(&bar[XB_XGEN(b.x)], 1u);
            asm volatile("s_waitcnt vmcnt(0)" ::: "memory");
        } else {
            XB_SPIN(xb_ld(&bar[XB_XGEN(b.x)]) == gen, bar);
            __builtin_amdgcn_fence(__ATOMIC_ACQUIRE, "agent");
            asm volatile("s_waitcnt vmcnt(0)" ::: "memory");
        }
    }
    __syncthreads();
}
__device__ __forceinline__ float wave_sum(float v) {
#pragma unroll
    for (int o = 1; o < 64; o <<= 1) v += __shfl_xor(v, o);
    return v;
}
__device__ __forceinline__ void p0_transpose_item(const float* W, int K, int N, bf16* WT, int row_off, LAS float* scr, int item, int lane) {
    const int nblk = N / 32, kb = item / nblk, nb = item % nblk, k0 = 64 * kb, n0 = 32 * nb;
#pragma unroll 8
    for (int i = 0; i < 32; ++i) { const int kk = 2 * i + (lane >> 5); scr[kk * 33 + (lane & 31)] = W[(size_t)(k0 + kk) * N + n0 + (lane & 31)]; }
    LDS_WAIT(); asm volatile("" ::: "memory");
    const int c = lane & 7;
#pragma unroll
    for (int j = 0; j < 4; ++j) { const int n = (lane >> 3) + 8 * j; const LAS float* s = scr + (8 * c) * 33 + n;
        v4u o; o.x = pk2(s[0 * 33], s[1 * 33]); o.y = pk2(s[2 * 33], s[3 * 33]); o.z = pk2(s[4 * 33], s[5 * 33]); o.w = pk2(s[6 * 33], s[7 * 33]);
        *(GAS v4u*)(WT + (size_t)(row_off + n0 + n) * K + k0 + 8 * c) = o; }
    LDS_WAIT(); asm volatile("" ::: "memory");
}
constexpr int NWAVES = 8;
#ifndef MK_N_LAUNCHES
#define MK_N_LAUNCHES 1
#endif
constexpr int PER_PHASE = 10;
constexpr int N_LAUNCHES = MK_N_LAUNCHES;
static_assert(N_LAUNCHES == 1 || N_LAUNCHES == PER_PHASE, "MK_N_LAUNCHES is 1 or 10");

constexpr size_t MiB = 1u << 20;
constexpr size_t WS_CTL = 0, CTL_ZERO_BYTES = 64 * 1024;
constexpr size_t WS_MOD = 1 * MiB;
constexpr size_t WS_ROPE = 2 * MiB;
constexpr size_t WS_WSGU = 3 * MiB;
constexpr size_t WS_WG = 4 * MiB;
constexpr size_t WS_WIN0T = 6 * MiB, WS_WOUT0T = 11 * MiB, WS_WIN1T = 13 * MiB, WS_WOUT1T = 21 * MiB;
constexpr size_t WS_STATS = 24 * MiB;
constexpr size_t WS_H = 64 * MiB;
constexpr size_t WS_P = 208 * MiB;
constexpr size_t WS_P1A = WS_P, WS_QB = WS_P + 256 * MiB, WS_GB = WS_P + 320 * MiB;
constexpr size_t WS_C = 592 * MiB;
constexpr size_t WS_D = 736 * MiB;
constexpr size_t WS_E = 880 * MiB;
constexpr size_t WS_END = 1008 * MiB;
constexpr int CW_TMO = 0, CW_BAR = 4096;

constexpr int RING_BYTES = 131072;
constexpr int LDSCTL_OFF = RING_BYTES, MISC_OFF = LDSCTL_OFF + 320;
constexpr int LDS_BYTES = 147456;

struct Ptrs {
    const float *x, *c, *ctx, *c_ctx, *w_mod, *b_mod, *ln_g, *ln_b, *ab_w_in, *ab_w_out, *conv_w, *conv_b, *w_a, *b_a, *w_x, *b_x, *lam, *sgu_g, *sgu_bl, *sgu_w, *sgu_bias,
                *cd_w_in, *cd_w_out, *sconv_w, *dlam, *subg;
    float* out;
    float *mod, *ropec, *ropes, *lamv, *stats;
    bf16 *wsgu, *wg, *win0t, *wout0t, *win1t, *wout1t, *H, *P0, *HF, *Y0, *Z0, *X1, *P1a, *Qb, *Gb, *KV, *Y1;
};

__device__ __forceinline__ float bfl(unsigned w) { return __uint_as_float(w << 16); }
__device__ __forceinline__ float bfh(unsigned w) { return __uint_as_float(w & 0xffff0000u); }
__device__ __forceinline__ float bf1(bf16 v) { return __uint_as_float((unsigned)v << 16); }
__device__ __forceinline__ int crow_(int r, int hi) { return (r & 3) + 8 * (r >> 2) + 4 * hi; }
typedef float f32x16_t __attribute__((ext_vector_type(16)));

__device__ __forceinline__ void phase_p0(const Ptrs& p, LAS unsigned char* lds, int vcu, int G, int tid, int wave, int lane) {
    for (int it = vcu; it < 96; it += G) {
        const int l = it / 48, j = (it % 48) * 64 + lane;
        const float* Wm = p.w_mod + (size_t)l * 1024 * 3072;
        LAS float* scr = (LAS float*)(lds + wave * 16384);
        float acc[33];
#pragma unroll
        for (int r = 0; r < 33; ++r) acc[r] = 0.f;
        for (int sub = 0; sub < 2; ++sub) {
            const int k0 = wave * 128 + sub * 64;
#pragma unroll
            for (int r = 0; r < 33; ++r) { float v = (r < 32) ? p.c[r * 1024 + k0 + lane] : p.c_ctx[k0 + lane]; v = v / (1.f + __expf(-v)); scr[lane * 36 + r] = v; }
            LDS_WAIT(); asm volatile("" ::: "memory");
            for (int kk = 0; kk < 64; ++kk) {
                const float w = Wm[(size_t)(k0 + kk) * 3072 + j];
#pragma unroll
                for (int r4 = 0; r4 < 8; ++r4) { const f32x4 s = *(const LAS f32x4*)(scr + kk * 36 + 4 * r4);
                    acc[4 * r4 + 0] += s.x * w; acc[4 * r4 + 1] += s.y * w; acc[4 * r4 + 2] += s.z * w; acc[4 * r4 + 3] += s.w * w; }
                acc[32] += scr[kk * 36 + 32] * w;
            }
            LDS_WAIT(); asm volatile("" ::: "memory");
        }
        __syncthreads();
        LAS float* red = (LAS float*)lds;
#pragma unroll
        for (int r = 0; r < 33; ++r) red[(wave * 33 + r) * 64 + lane] = acc[r];
        __syncthreads();
        for (int r = wave; r < 33; r += 8) { float s = p.b_mod[l * 3072 + j];
#pragma unroll
            for (int w2 = 0; w2 < 8; ++w2) s += red[(w2 * 33 + r) * 64 + lane];
            p.mod[((size_t)l * 33 + r) * 3072 + j] = s; }
        __syncthreads();
    }
    {
        LAS float* scr = (LAS float*)(lds + wave * 16384);
        const int gw = vcu * NWAVES + wave, NGW = G * NWAVES;
        constexpr int I_IN0 = (DM / 64) * (N_AB / 32), I_OUT = (DM / 64) * (DM / 32), I_IN1 = (DM / 64) * (N_CD / 32);
        constexpr int NITEMS = I_IN0 + I_OUT + I_IN1 + I_OUT;
        for (int it = gw; it < NITEMS; it += NGW) {
            int r = it;
            if (r < I_IN0) { p0_transpose_item(p.ab_w_in, DM, N_AB, p.win0t, 0, scr, r, lane); continue; } r -= I_IN0;
            if (r < I_OUT) { p0_transpose_item(p.ab_w_out, DM, DM, p.wout0t, 0, scr, r, lane); continue; } r -= I_OUT;
            if (r < I_IN1) { p0_transpose_item(p.cd_w_in, DM, N_CD, p.win1t, 0, scr, r, lane); continue; } r -= I_IN1;
            p0_transpose_item(p.cd_w_out, DM, DM, p.wout1t, 0, scr, r, lane);
        }
        if (gw == NGW - 1) {
            for (int idx = lane; idx < 1024; idx += 64) { const int pos = idx >> 4, f = idx & 15; const float inv = powf(10000.0f, -(float)f / 16.0f); const float ang = (float)pos * inv;
                p.ropec[idx] = cosf(ang); p.ropes[idx] = sinf(ang); }
        }
        if (gw == NGW - 2) {
            const float a = wave_sum(p.dlam[lane] * p.dlam[64 + lane]), b2 = wave_sum(p.dlam[128 + lane] * p.dlam[192 + lane]);
            if (lane == 0) p.lamv[0] = expf(a) - expf(b2) + LAM_INIT;
        }
        const int gt = (vcu * NWAVES + wave) * 64 + lane, NGT = G * NWAVES * 64;
        for (int i = gt; i < 4 * 128 * 128; i += NGT) p.wsgu[i] = (bf16)f2bf(p.sgu_w[i]);
        for (int i = gt; i < 2 * 8 * 2 * 64 * 64; i += NGT) {
            const int ii = i & 63, jj = (i >> 6) & 63, gate = (i >> 12) & 1, dh = i >> 13;
            const float* src = gate ? p.w_x : p.w_a;
            p.wg[i] = (bf16)f2bf(src[(dh * 64 + ii) * 64 + jj]);
        }
    }
}

__device__ __forceinline__ void h0_rows(const float* src, const float* modrow, bf16* dst, int r0, int r1, int lane) {
    f32x4 sc[4], sh[4];
#pragma unroll
    for (int j = 0; j < 4; ++j) { sh[j] = *(const f32x4*)(modrow + 4 * lane + 256 * j); sc[j] = *(const f32x4*)(modrow + 1024 + 4 * lane + 256 * j) + 1.0f; }
    for (int row = r0; row < r1; ++row) {
        const f32x4* xr = (const f32x4*)(src + (size_t)row * DM) + lane;
        unsigned long long* o8 = (unsigned long long*)(dst + (size_t)row * DM) + lane;
#pragma unroll
        for (int j = 0; j < 4; ++j) { const f32x4 v = xr[64 * j] * sc[j] + sh[j];
            o8[64 * j] = (unsigned long long)pk2(v.x, v.y) | ((unsigned long long)pk2(v.z, v.w) << 32); }
    }
}
__device__ __forceinline__ void phase_h0(const Ptrs& p, int gw, int NGW, int lane) {
    {   const int rpw = (ML + NGW - 1) / NGW; int r0 = gw * rpw, r1 = r0 + rpw; if (r1 > ML) r1 = ML;
        while (r0 < r1) { const int b = r0 / SEQ; int re = (b + 1) * SEQ; if (re > r1) re = r1;
            h0_rows(p.x, p.mod + (size_t)b * 3072, p.H, r0, re, lane); r0 = re; } }
    {   const int rpw = (MC + NGW - 1) / NGW; int r0 = gw * rpw, r1 = r0 + rpw; if (r1 > MC) r1 = MC;
        if (r0 < r1) h0_rows(p.ctx, p.mod + (size_t)32 * 3072, p.H + (size_t)ML * DM, r0, r1, lane); }
}

__device__ __forceinline__ void lru_unit(const Ptrs& p, LAS unsigned char* lds, int b, int hd, int tid, int wave, int lane) {
    LAS float* XS = (LAS float*)lds;
    LAS float* AA = (LAS float*)lds;
    LAS float* BB = (LAS float*)(lds + 32768);
    LAS float* XC = (LAS float*)(lds + 65536);
    LAS unsigned short* XB = (LAS unsigned short*)(lds + 98304);
    LAS float* SEG = (LAS float*)(lds + 98304 + 18432);
    LAS float* CAR = (LAS float*)(lds + 98304 + 18432 + 4096);
    const int tt = wave >> 1, jt = wave & 1, r32 = lane & 31, hi = lane >> 5;
    const int c = tid & 63, tg = tid >> 6;
    const int chg = hd * 64 + c;
    const float cw0 = p.conv_w[0 * BW + chg], cw1 = p.conv_w[1 * BW + chg], cw2 = p.conv_w[2 * BW + chg], cw3 = p.conv_w[3 * BW + chg], cbias = p.conv_b[chg];
    for (int d = 0; d < 2; ++d) {
        const int chj = hd * 64 + 32 * jt + r32;
        const float ba = p.b_a[d * BW + chj], bx = p.b_x[d * BW + chj];
        const float sp8 = 8.0f * log1pf(expf(-p.lam[d * BW + chj]));
        bf16x8 wa[4], wx[4];
#pragma unroll
        for (int ks = 0; ks < 4; ++ks) {
            wa[ks] = *(const bf16x8*)(p.wg + ((size_t)(((d * 8 + hd) * 2 + 0) * 64 + 32 * jt + r32)) * 64 + 16 * ks + 8 * hi);
            wx[ks] = *(const bf16x8*)(p.wg + ((size_t)(((d * 8 + hd) * 2 + 1) * 64 + 32 * jt + r32)) * 64 + 16 * ks + 8 * hi);
        }
        if (tid < 64) CAR[tid] = 0.f;
        __syncthreads();
        for (int k = 0; k < 18; ++k) {
            const bool isctx = k < 2;
            const int ck = (d == 0) ? (isctx ? k : k - 2) : (isctx ? 1 - k : 17 - k);
            const int n = isctx ? CTXL : SEQ, rowbase = isctx ? ML + b * CTXL : b * SEQ, t0 = ck * 128;
            for (int idx = tid; idx < 131 * 8; idx += 512) { const int i = idx >> 3, c8 = (idx & 7) * 8, t = t0 - 2 + i;
                f32x4 v0 = {0.f, 0.f, 0.f, 0.f}, v1 = {0.f, 0.f, 0.f, 0.f};
                if (t >= 0 && t < n) { const v4u w = *(const v4u*)(p.P0 + (size_t)(rowbase + t) * N_AB + hd * 64 + c8);
                    v0 = (f32x4){bfl(w.x), bfh(w.x), bfl(w.y), bfh(w.y)}; v1 = (f32x4){bfl(w.z), bfh(w.z), bfl(w.w), bfh(w.w)}; }
                *(LAS f32x4*)(XS + i * 64 + c8) = v0; *(LAS f32x4*)(XS + i * 64 + c8 + 4) = v1; }
            __syncthreads();
#pragma unroll 4
            for (int tl = 0; tl < 16; ++tl) { const int t = 16 * tg + tl;
                const float xc = cbias + cw0 * XS[(t + 0) * 64 + c] + cw1 * XS[(t + 1) * 64 + c] + cw2 * XS[(t + 2) * 64 + c] + cw3 * XS[(t + 3) * 64 + c];
                XC[t * 64 + c] = xc; XB[t * 72 + c] = (unsigned short)f2bf(xc); }
            __syncthreads();
            {   f32x16_t accA = {}, accX = {};
#pragma unroll
                for (int ks = 0; ks < 4; ++ks) { const bf16x8 a = *(const LAS bf16x8*)(XB + (32 * tt + r32) * 72 + 16 * ks + 8 * hi);
                    accA = __builtin_amdgcn_mfma_f32_32x32x16_bf16(a, wa[ks], accA, 0, 0, 0);
                    accX = __builtin_amdgcn_mfma_f32_32x32x16_bf16(a, wx[ks], accX, 0, 0, 0); }
#pragma unroll
                for (int r = 0; r < 16; ++r) { const int t = 32 * tt + crow_(r, hi), j = 32 * jt + r32;
                    const float xc = XC[t * 64 + j];
                    const float gr = 1.0f / (1.0f + __expf(-(accA[r] + ba))), gi = 1.0f / (1.0f + __expf(-(accX[r] + bx)));
                    const float la = -gr * sp8;
                    const float av = expf(la), bt = sqrtf(-expm1f(2.0f * la)) * (gi * xc);
                    AA[t * 64 + j] = av; BB[t * 64 + j] = bt; }
            }
            __syncthreads();
            {   float A = 1.f, Hh = 0.f;
#pragma unroll 4
                for (int pl = 0; pl < 16; ++pl) { const int q = 16 * tg + pl, t = d ? 127 - q : q; const float av = AA[t * 64 + c], bv = BB[t * 64 + c]; Hh = av * Hh + bv; A *= av; }
                SEG[(tg * 64 + c) * 2] = A; SEG[(tg * 64 + c) * 2 + 1] = Hh;
            }
            __syncthreads();
            {   const int par = k & 1; float h = CAR[par * 64 + c];
                for (int s2 = 0; s2 < tg; ++s2) h = SEG[(s2 * 64 + c) * 2] * h + SEG[(s2 * 64 + c) * 2 + 1];
#pragma unroll 4
                for (int pl = 0; pl < 16; ++pl) { const int q = 16 * tg + pl, t = d ? 127 - q : q; const float av = AA[t * 64 + c], bv = BB[t * 64 + c]; h = av * h + bv;
                    const size_t row = (size_t)(rowbase + t0 + t);
                    if (d == 0) p.HF[row * BW + chg] = (bf16)f2bf(h);
                    else { const float hf = bf1(p.HF[row * BW + chg]), g = bf1(p.P0[row * N_AB + BW + chg]); p.Y0[row * DM + chg] = (bf16)f2bf((hf + h) * g); } }
                if (tg == 7) CAR[(par ^ 1) * 64 + c] = h;
            }
            __syncthreads();
        }
    }
}

__device__ __forceinline__ void sgu_unit(const Ptrs& p, LAS unsigned char* lds, int unit, int tid, int wave, int lane) {
    const int row0 = (unit < 512) ? unit * 128 : ML + (unit - 512) * 128;
    LAS float* STAT = (LAS float*)(lds + 32768);
    LAS float* SS = (LAS float*)(lds + 36864);
    char* Vl = (char*)lds;
    for (int i = 0; i < 16; ++i) { const int tk = wave * 16 + i;
        const v4u w = *(const v4u*)(p.P0 + (size_t)(row0 + tk) * N_AB + 3 * BW + 8 * lane);
        const float e0 = bfl(w.x), e1 = bfh(w.x), e2 = bfl(w.y), e3 = bfh(w.y), e4 = bfl(w.z), e5 = bfh(w.z), e6 = bfl(w.w), e7 = bfh(w.w);
        const float s = wave_sum(((e0 + e1) + (e2 + e3)) + ((e4 + e5) + (e6 + e7)));
        const float mean = s * (1.0f / 512.0f);
        const float d0 = e0 - mean, d1 = e1 - mean, d2 = e2 - mean, d3 = e3 - mean, d4 = e4 - mean, d5 = e5 - mean, d6 = e6 - mean, d7 = e7 - mean;
        const float q = wave_sum(((d0 * d0 + d1 * d1) + (d2 * d2 + d3 * d3)) + ((d4 * d4 + d5 * d5) + (d6 * d6 + d7 * d7)));
        if (lane == 0) { STAT[tk * 2] = mean; STAT[tk * 2 + 1] = 1.0f / sqrtf(q * (1.0f / 512.0f) + LN_EPS); } }
    __syncthreads();
    const int sr = tid >> 4, sc = (tid & 15) * 8;
    const int pt = wave & 3, ch = wave >> 2, r32 = lane & 31, hi = lane >> 5;
    const int vb0 = (int)(uintptr_t)Vl + att::v_rd_base(lane);
#pragma unroll 1
    for (int g = 0; g < 4; ++g) {
        {   f32x4 lg0 = *(const f32x4*)(p.sgu_g + g * 128 + sc), lg1 = *(const f32x4*)(p.sgu_g + g * 128 + sc + 4);
            f32x4 lb0 = *(const f32x4*)(p.sgu_bl + g * 128 + sc), lb1 = *(const f32x4*)(p.sgu_bl + g * 128 + sc + 4);
#pragma unroll
            for (int tile = 0; tile < 2; ++tile)
#pragma unroll
                for (int half = 0; half < 2; ++half) { const int kk = half * 32 + sr, tk = tile * 64 + kk;
                    const v4u w = *(const v4u*)(p.P0 + (size_t)(row0 + tk) * N_AB + 3 * BW + g * 128 + sc);
                    const float mean = STAT[tk * 2], rstd = STAT[tk * 2 + 1];
                    f32x4 v0 = {bfl(w.x), bfh(w.x), bfl(w.y), bfh(w.y)}, v1 = {bfl(w.z), bfh(w.z), bfl(w.w), bfh(w.w)};
                    v0 = (v0 - mean) * rstd * lg0 + lb0; v1 = (v1 - mean) * rstd * lg1 + lb1;
                    v4u o; o.x = pk2(v0.x, v0.y); o.y = pk2(v0.z, v0.w); o.z = pk2(v1.x, v1.y); o.w = pk2(v1.z, v1.w);
                    *(v4u*)(Vl + tile * 16384 + att::v_st(kk, sc)) = o; }
        }
        __syncthreads();
        f32x16_t o0 = {}, o1 = {};
        {   bf16x8 pa[8];
#pragma unroll
            for (int ks = 0; ks < 8; ++ks) pa[ks] = *(const bf16x8*)(p.wsgu + ((size_t)(g * 128 + 32 * pt + r32)) * 128 + 16 * ks + 8 * hi);
            if (ch == 0) {
                att::pv_one<0>(o0, vb0, pa[0], pa[1], pa[2], pa[3]); att::pv_one<1>(o1, vb0, pa[0], pa[1], pa[2], pa[3]);
                att::pv_one<0>(o0, vb0 + 16384, pa[4], pa[5], pa[6], pa[7]); att::pv_one<1>(o1, vb0 + 16384, pa[4], pa[5], pa[6], pa[7]);
            } else {
                att::pv_one<2>(o0, vb0, pa[0], pa[1], pa[2], pa[3]); att::pv_one<3>(o1, vb0, pa[0], pa[1], pa[2], pa[3]);
                att::pv_one<2>(o0, vb0 + 16384, pa[4], pa[5], pa[6], pa[7]); att::pv_one<3>(o1, vb0 + 16384, pa[4], pa[5], pa[6], pa[7]);
            }
        }
#pragma unroll
        for (int r = 0; r < 16; ++r) { const int pp = 32 * pt + crow_(r, hi);
            SS[pp * 128 + (2 * ch) * 32 + r32] = o0[r]; SS[pp * 128 + (2 * ch + 1) * 32 + r32] = o1[r]; }
        __syncthreads();
#pragma unroll
        for (int it = 0; it < 4; ++it) { const int idx = tid + 512 * it, pp = idx >> 4, c8 = (idx & 15) * 8; const size_t row = (size_t)(row0 + pp);
            const float bs = p.sgu_bias[g * 128 + pp];
            const f32x4 s0 = *(const LAS f32x4*)(SS + pp * 128 + c8) + bs, s1 = *(const LAS f32x4*)(SS + pp * 128 + c8 + 4) + bs;
            const v4u uw = *(const v4u*)(p.P0 + row * N_AB + 2 * BW + g * 128 + c8), gw4 = *(const v4u*)(p.P0 + row * N_AB + 4 * BW + g * 128 + c8);
            const f32x4 u0 = {bfl(uw.x), bfh(uw.x), bfl(uw.y), bfh(uw.y)}, u1 = {bfl(uw.z), bfh(uw.z), bfl(uw.w), bfh(uw.w)};
            const f32x4 g0 = {bfl(gw4.x), bfh(gw4.x), bfl(gw4.y), bfh(gw4.y)}, g1 = {bfl(gw4.z), bfh(gw4.z), bfl(gw4.w), bfh(gw4.w)};
            const f32x4 y0 = u0 * s0 * g0, y1 = u1 * s1 * g1;
            v4u o; o.x = pk2(y0.x, y0.y); o.y = pk2(y0.z, y0.w); o.z = pk2(y1.x, y1.y); o.w = pk2(y1.z, y1.w);
            *(v4u*)(p.Y0 + row * DM + BW + g * 128 + c8) = o; }
    }
}

__device__ __forceinline__ void phase_lnmid(const Ptrs& p, int gw, int NGW, int lane) {
    const int rpw = (MT + NGW - 1) / NGW; int r0 = gw * rpw, r1 = r0 + rpw; if (r1 > MT) r1 = MT;
    const int ca = 8 * lane, cb = 512 + 8 * lane;
    f32x4 g[4], bb[4], sc[4], sh[4];
    g[0] = *(const f32x4*)(p.ln_g + ca); g[1] = *(const f32x4*)(p.ln_g + ca + 4); g[2] = *(const f32x4*)(p.ln_g + cb); g[3] = *(const f32x4*)(p.ln_g + cb + 4);
    bb[0] = *(const f32x4*)(p.ln_b + ca); bb[1] = *(const f32x4*)(p.ln_b + ca + 4); bb[2] = *(const f32x4*)(p.ln_b + cb); bb[3] = *(const f32x4*)(p.ln_b + cb + 4);
    int curb = -1;
    for (int row = r0; row < r1; ++row) {
        const int b = (row < ML) ? row / SEQ : 32;
        if (b != curb) { curb = b; const float* m1 = p.mod + (size_t)(33 + b) * 3072;
            sh[0] = *(const f32x4*)(m1 + ca); sh[1] = *(const f32x4*)(m1 + ca + 4); sh[2] = *(const f32x4*)(m1 + cb); sh[3] = *(const f32x4*)(m1 + cb + 4);
            sc[0] = *(const f32x4*)(m1 + 1024 + ca) + 1.0f; sc[1] = *(const f32x4*)(m1 + 1024 + ca + 4) + 1.0f; sc[2] = *(const f32x4*)(m1 + 1024 + cb) + 1.0f; sc[3] = *(const f32x4*)(m1 + 1024 + cb + 4) + 1.0f; }
        const v4u za = *(const v4u*)(p.Z0 + (size_t)row * DM + ca), zb = *(const v4u*)(p.Z0 + (size_t)row * DM + cb);
        float s = 0.f, q = 0.f;
        if (lane < 16) { s = p.stats[((size_t)row * 16 + lane) * 2]; q = p.stats[((size_t)row * 16 + lane) * 2 + 1]; }
        s = wave_sum(s); q = wave_sum(q);
        const float mean = s * (1.0f / DM), var = q * (1.0f / DM) - mean * mean, rstd = 1.0f / sqrtf(var + LN_EPS);
        f32x4 z[4] = {{bfl(za.x), bfh(za.x), bfl(za.y), bfh(za.y)}, {bfl(za.z), bfh(za.z), bfl(za.w), bfh(za.w)}, {bfl(zb.x), bfh(zb.x), bfl(zb.y), bfh(zb.y)}, {bfl(zb.z), bfh(zb.z), bfl(zb.w), bfh(zb.w)}};
        f32x4 x1[4], h1[4];
#pragma unroll
        for (int i = 0; i < 4; ++i) { x1[i] = (z[i] - mean) * rstd * g[i] + bb[i]; h1[i] = x1[i] * sc[i] + sh[i]; }
        if (row < ML) {
            v4u o; o.x = pk2(x1[0].x, x1[0].y); o.y = pk2(x1[0].z, x1[0].w); o.z = pk2(x1[1].x, x1[1].y); o.w = pk2(x1[1].z, x1[1].w); *(v4u*)(p.X1 + (size_t)row * DM + ca) = o;
            o.x = pk2(x1[2].x, x1[2].y); o.y = pk2(x1[2].z, x1[2].w); o.z = pk2(x1[3].x, x1[3].y); o.w = pk2(x1[3].z, x1[3].w); *(v4u*)(p.X1 + (size_t)row * DM + cb) = o; }
        {   v4u o; o.x = pk2(h1[0].x, h1[0].y); o.y = pk2(h1[0].z, h1[0].w); o.z = pk2(h1[1].x, h1[1].y); o.w = pk2(h1[1].z, h1[1].w); *(v4u*)(p.H + (size_t)row * DM + ca) = o;
            o.x = pk2(h1[2].x, h1[2].y); o.y = pk2(h1[2].z, h1[2].w); o.z = pk2(h1[3].x, h1[3].y); o.w = pk2(h1[3].z, h1[3].w); *(v4u*)(p.H + (size_t)row * DM + cb) = o; }
    }
}

__device__ __forceinline__ void convgate_item(const Ptrs& p, int item, int lane) {
    const int b = item >> 6, t0 = (item & 63) * 32, c0 = 8 * lane;
    f32x4 w[3][2];
#pragma unroll
    for (int k = 0; k < 3; ++k) { w[k][0] = *(const f32x4*)(p.sconv_w + k * BW + c0); w[k][1] = *(const f32x4*)(p.sconv_w + k * BW + c0 + 4); }
    const bf16* base = p.P1a + (size_t)b * SEQ * 2048;
    auto prod = [&](int t, f32x4& a0, f32x4& a1) {
        if (t < 0 || t >= SEQ) { a0 = (f32x4){0.f, 0.f, 0.f, 0.f}; a1 = a0; return; }
        const v4u hh = *(const v4u*)(base + (size_t)t * 2048 + c0), cc = *(const v4u*)(base + (size_t)t * 2048 + 2 * BW + c0);
        a0 = (f32x4){bfl(hh.x) * bfl(cc.x), bfh(hh.x) * bfh(cc.x), bfl(hh.y) * bfl(cc.y), bfh(hh.y) * bfh(cc.y)};
        a1 = (f32x4){bfl(hh.z) * bfl(cc.z), bfh(hh.z) * bfh(cc.z), bfl(hh.w) * bfl(cc.w), bfh(hh.w) * bfh(cc.w)}; };
    f32x4 pm0, pm1, pc0, pc1, pn0, pn1;
    prod(t0 - 1, pm0, pm1); prod(t0, pc0, pc1);
    for (int t = t0; t < t0 + 32; ++t) {
        prod(t + 1, pn0, pn1);
        const v4u bbv = *(const v4u*)(base + (size_t)t * 2048 + BW + c0), ggv = *(const v4u*)(base + (size_t)t * 2048 + 3 * BW + c0);
        const f32x4 cv0 = w[0][0] * pm0 + w[1][0] * pc0 + w[2][0] * pn0, cv1 = w[0][1] * pm1 + w[1][1] * pc1 + w[2][1] * pn1;
        const f32x4 b0 = {bfl(bbv.x), bfh(bbv.x), bfl(bbv.y), bfh(bbv.y)}, b1 = {bfl(bbv.z), bfh(bbv.z), bfl(bbv.w), bfh(bbv.w)};
        const f32x4 g0 = {bfl(ggv.x), bfh(ggv.x), bfl(ggv.y), bfh(ggv.y)}, g1 = {bfl(ggv.z), bfh(ggv.z), bfl(ggv.w), bfh(ggv.w)};
        const f32x4 y0 = b0 * cv0 * g0, y1 = b1 * cv1 * g1;
        v4u o; o.x = pk2(y0.x, y0.y); o.y = pk2(y0.z, y0.w); o.z = pk2(y1.x, y1.y); o.w = pk2(y1.z, y1.w);
        *(v4u*)(p.Y1 + ((size_t)b * SEQ + t) * DM + c0) = o;
        pm0 = pc0; pm1 = pc1; pc0 = pn0; pc1 = pn1;
    }
}

__device__ __forceinline__ void phase_final(const Ptrs& p, int gw, int NGW, int lane) {
    const int rpw = (ML + NGW - 1) / NGW; int r0 = gw * rpw, r1 = r0 + rpw; if (r1 > ML) r1 = ML;
    f32x4 g[4], bb[4];
#pragma unroll
    for (int j = 0; j < 4; ++j) { g[j] = *(const f32x4*)(p.ln_g + DM + 4 * lane + 256 * j); bb[j] = *(const f32x4*)(p.ln_b + DM + 4 * lane + 256 * j); }
    for (int row = r0; row < r1; ++row) {
        f32x4* zr = (f32x4*)(p.out + (size_t)row * DM) + lane;
        f32x4 z[4];
#pragma unroll
        for (int j = 0; j < 4; ++j) z[j] = zr[64 * j];
        float s = 0.f, q = 0.f;
        if (lane < 16) { s = p.stats[((size_t)row * 16 + lane) * 2]; q = p.stats[((size_t)row * 16 + lane) * 2 + 1]; }
        s = wave_sum(s); q = wave_sum(q);
        const float mean = s * (1.0f / DM), var = q * (1.0f / DM) - mean * mean, rstd = 1.0f / sqrtf(var + LN_EPS);
#pragma unroll
        for (int j = 0; j < 4; ++j) zr[64 * j] = (z[j] - mean) * rstd * g[j] + bb[j];
    }
}

struct OrderG3 {
    pg8::StaticOrder so; int G, c;
    __device__ void init(int G_, int c_) { so.init(ML, N_CD, G_, c_); G = G_; c = c_; }
    __device__ bool next(int i, pg8::Unit& u) const {
        if (so.next(i, u)) return true;
        const long L = (long)i * G + c - (long)(ML / 256) * (N_CD / 256);
        if (L < 0 || L >= (MC / 256) * 4) return false;
        u.pm = ML / 256 + (int)(L >> 2); u.pn = 10 + (int)(L & 3); return true;
    }
    __device__ __forceinline__ void a_ready(const pg8::Unit&) const {}
    __device__ __forceinline__ void done(const pg8::Unit&) const {}
};

struct Args { const float* in[26]; float* out; unsigned char* ws; int ph_lo, ph_hi, li, pad; };
__global__ void __launch_bounds__(NWAVES * 64, 2) mk_fwd(Args args) {
    extern __shared__ __attribute__((aligned(16))) unsigned char lds[];
    LAS unsigned char* L = (LAS unsigned char*)lds;
    const int tid = threadIdx.x, lane = tid & 63, wave = __builtin_amdgcn_readfirstlane(tid >> 6);
    const int G = gridDim.x; const int bx = blockIdx.x; const int vcu = (G % 8 == 0) ? (bx % 8) * (G / 8) + bx / 8 : bx;
    const int gw = vcu * NWAVES + wave, NGW = G * NWAVES;
    unsigned char* ws = args.ws;
    Ptrs p;
    p.x = args.in[0]; p.c = args.in[1]; p.ctx = args.in[2]; p.c_ctx = args.in[3]; p.w_mod = args.in[4]; p.b_mod = args.in[5]; p.ln_g = args.in[6]; p.ln_b = args.in[7];
    p.ab_w_in = args.in[8]; p.ab_w_out = args.in[9]; p.conv_w = args.in[10]; p.conv_b = args.in[11]; p.w_a = args.in[12]; p.b_a = args.in[13]; p.w_x = args.in[14]; p.b_x = args.in[15];
    p.lam = args.in[16]; p.sgu_g = args.in[17]; p.sgu_bl = args.in[18]; p.sgu_w = args.in[19]; p.sgu_bias = args.in[20]; p.cd_w_in = args.in[21]; p.cd_w_out = args.in[22];
    p.sconv_w = args.in[23]; p.dlam = args.in[24]; p.subg = args.in[25]; p.out = args.out;
    p.mod = (float*)(ws + WS_MOD); p.ropec = (float*)(ws + WS_ROPE); p.ropes = p.ropec + 1024; p.lamv = p.ropec + 2048; p.stats = (float*)(ws + WS_STATS);
    p.wsgu = (bf16*)(ws + WS_WSGU); p.wg = (bf16*)(ws + WS_WG); p.win0t = (bf16*)(ws + WS_WIN0T); p.wout0t = (bf16*)(ws + WS_WOUT0T); p.win1t = (bf16*)(ws + WS_WIN1T); p.wout1t = (bf16*)(ws + WS_WOUT1T);
    p.H = (bf16*)(ws + WS_H); p.P0 = (bf16*)(ws + WS_P); p.HF = (bf16*)(ws + WS_D); p.Y0 = (bf16*)(ws + WS_C); p.Z0 = (bf16*)(ws + WS_D); p.X1 = (bf16*)(ws + WS_E);
    p.P1a = (bf16*)(ws + WS_P1A); p.Qb = (bf16*)(ws + WS_QB); p.Gb = (bf16*)(ws + WS_GB); p.KV = (bf16*)(ws + WS_C); p.Y1 = (bf16*)(ws + WS_D);
    gu32* ctl = (gu32*)(ws + WS_CTL);

    for (int u = tid; u < (LDS_BYTES - LDSCTL_OFF) / 4; u += NWAVES * 64) ((LAS unsigned*)(L + LDSCTL_OFF))[u] = 0u;
    __syncthreads();
    XcdBarrier bar; bar.bar = (unsigned*)(ctl + CW_BAR); bar.x = 0; bar.st = nullptr;
    if (N_LAUNCHES == 1) bar = xcd_barrier_post((unsigned*)(ctl + CW_BAR), (volatile LAS unsigned*)(L + MISC_OFF) + 8);
#define GRID_BAR() do { if (N_LAUNCHES == 1) xcd_barrier(bar); } while (0)
    const int lo = args.ph_lo, hi = args.ph_hi;
#ifndef PH_MASK
#define PH_MASK 0x3ff
#endif
#define IN(k) ((((PH_MASK) >> (k)) & 1) && lo <= (k) && (k) < hi)
#define BOTH(k) (IN(k) && IN((k) + 1))

    if (IN(0)) { phase_p0(p, L, vcu, G, tid, wave, lane); if (BOTH(0)) GRID_BAR(); }
    if (IN(1)) { phase_h0(p, gw, NGW, lane); if (BOTH(1)) GRID_BAR(); }
    if (IN(2)) {
        pg8::Gemm g{p.H, p.win0t, MT, N_AB, DM}; pg8::StaticOrder S; S.init(MT, N_AB, G, bx);
        pg8::EpiAct1 E{p.P0};
        pg8::gemm_phase<pg8::EpiAct1, pg8::StaticOrder, true, true>(L, g, S, E);
        if (BOTH(2)) GRID_BAR();
    }
    if (IN(3)) {
#ifndef NO_LRU
        for (int u = vcu; u < NB * 8; u += G) lru_unit(p, L, u >> 3, u & 7, tid, wave, lane);
#endif
#ifndef NO_SGU
        for (int u = vcu; u < (MT / 128); u += G) sgu_unit(p, L, u, tid, wave, lane);
#endif
        if (BOTH(3)) GRID_BAR();
    }
    if (IN(4)) {
        pg8::Gemm g{p.Y0, p.wout0t, MT, DM, DM}; pg8::StaticOrder S; S.init(MT, DM, G, bx);
        pg8::EpiZ<false> E{p.x, p.ctx, nullptr, p.mod, p.Z0, nullptr, p.stats};
        pg8::gemm_phase<pg8::EpiZ<false>, pg8::StaticOrder, true, true>(L, g, S, E);
        if (BOTH(4)) GRID_BAR();
    }
    if (IN(5)) { phase_lnmid(p, gw, NGW, lane); if (BOTH(5)) GRID_BAR(); }
    if (IN(6)) {
        pg8::Gemm g{p.H, p.win1t, MT, N_CD, DM}; OrderG3 S; S.init(G, bx);
        pg8::EpiP1 E{p.P1a, p.Qb, p.KV, p.Gb, p.ropec, p.ropes};
        pg8::gemm_phase<pg8::EpiP1, OrderG3, true, true>(L, g, S, E);
        if (BOTH(6)) GRID_BAR();
    }
    if (IN(7)) {
        for (int it = gw; it < NB * 64; it += NGW) convgate_item(p, it, lane);
        const float lam = p.lamv[0];
        const int xcd = vcu / (G / 8 > 0 ? G / 8 : 1), jl = vcu % (G / 8 > 0 ? G / 8 : 1);
        if (G == 256) {
            for (int i = 0; i < 8; ++i) { const int pair = xcd * 16 + i * 2 + (jl >> 4), qb = jl & 15;
                att::attn_unit((const att::bf16*)p.Qb, (const att::bf16*)p.KV, (const att::bf16*)p.Gb, (att::bf16*)p.Y1, p.subg, lam, pair >> 2, pair & 3, qb, (char*)lds); }
        } else {
            for (int u = vcu; u < NB * 4 * 16; u += G) att::attn_unit((const att::bf16*)p.Qb, (const att::bf16*)p.KV, (const att::bf16*)p.Gb, (att::bf16*)p.Y1, p.subg, lam, u >> 6, (u >> 4) & 3, u & 15, (char*)lds);
        }
        if (BOTH(7)) GRID_BAR();
    }
    if (IN(8)) {
        pg8::Gemm g{p.Y1, p.wout1t, ML, DM, DM}; pg8::StaticOrder S; S.init(ML, DM, G, bx);
        pg8::EpiZ<true> E{nullptr, nullptr, (const pg8::bf16_t*)p.X1, p.mod + 33 * 3072, nullptr, p.out, p.stats};
        pg8::gemm_phase<pg8::EpiZ<true>, pg8::StaticOrder, true, true>(L, g, S, E);
        if (BOTH(8)) GRID_BAR();
    }
    if (IN(9)) { phase_final(p, gw, NGW, lane); }
#undef IN
#undef BOTH
#undef GRID_BAR
}

extern "C" void kernel_launch(void* const* d_in, const int* in_sizes, int n_in, void* d_out, int out_size, void* d_ws, size_t ws_size, hipStream_t stream) {
    static int grid = 0;
    if (grid == 0) {
        if (n_in != 26 || in_sizes[0] != ML * DM || out_size != ML * DM || ws_size < WS_END) {
            fprintf(stderr, "kernel_launch: built for 26 inputs, x/out of %d floats, >= %zu bytes of workspace; got n_in %d, in0 %d, out %d, ws %zu; nothing launched\n", ML * DM, (size_t)WS_END, n_in, n_in > 0 ? in_sizes[0] : -1, out_size, ws_size);
            grid = -1; return; }
        int dev = 0, cus = 0;
        if (hipGetDevice(&dev) != hipSuccess || hipDeviceGetAttribute(&cus, hipDeviceAttributeMultiprocessorCount, dev) != hipSuccess) { fprintf(stderr, "kernel_launch: device query failed\n"); grid = -1; return; }
        if (hipFuncSetAttribute((const void*)mk_fwd, hipFuncAttributeMaxDynamicSharedMemorySize, LDS_BYTES) != hipSuccess) { fprintf(stderr, "kernel_launch: hipFuncSetAttribute failed\n"); grid = -1; return; }
        (void)hipGetLastError();
        grid = cus;
    }
    if (grid < 0) return;
    if (hipMemsetAsync((char*)d_ws + WS_CTL, 0, CTL_ZERO_BYTES, stream) != hipSuccess) { fprintf(stderr, "kernel_launch: hipMemsetAsync failed\n"); return; }
    Args a{};
    for (int i = 0; i < 26; ++i) a.in[i] = (const float*)d_in[i];
    a.out = (float*)d_out; a.ws = (unsigned char*)d_ws;
    for (int li = 0; li < N_LAUNCHES; ++li) {
        a.ph_lo = (N_LAUNCHES == PER_PHASE) ? li : 0; a.ph_hi = (N_LAUNCHES == PER_PHASE) ? li + 1 : PER_PHASE; a.li = li;
        hipLaunchKernelGGL(mk_fwd, dim3(grid), dim3(NWAVES * 64), LDS_BYTES, stream, a);
        const hipError_t le = hipPeekAtLastError();
        if (le != hipSuccess) { fprintf(stderr, "kernel_launch: launch %d failed: %s\n", li, hipGetErrorName(le)); break; }
    }
}
```
